# Optimizing an MI355X kernel written in HIP

```python
import jax, jax.numpy as jnp
from jax import lax
import numpy as np

D_MODEL = 2048
BATCH = 2
SEQ = 8192
DEPTH = 4

CHUNK = 64
Q_BLOCK = 128
N_MIXERS = 3
RMS_EPS = 1e-6
SB_HEADS = 16
SB_HEAD_DIM = D_MODEL // SB_HEADS
HG_HEADS = 16
HG_KEY_DIM = D_MODEL // HG_HEADS
HG_VAL_DIM = D_MODEL // HG_HEADS
HG_WIDTH = HG_HEADS * HG_KEY_DIM
MLA_HEADS = 16
MLA_NOPE = 128
MLA_ROPE = 64
MLA_V = 128
MLA_Q_RANK = 768
MLA_KV_RANK = 512
ROPE_THETA = 10000.0
D_FF = 4 * D_MODEL

kernel_name = "hybrid_stickbreak_hgrn2_mla_stream"


def _n_layers_of(m):
    return len(range(m, DEPTH, N_MIXERS))


def rms_norm(x, g):
    xf = x.astype(jnp.float32)
    y = xf * lax.rsqrt(jnp.mean(xf * xf, axis=-1, keepdims=True) + RMS_EPS)
    return (y * g.astype(jnp.float32)).astype(x.dtype)


def _sweep_query_blocks(block_fn, queries):
    B, S = queries[0].shape[:2]
    nb = S // Q_BLOCK
    blocked = tuple(a.reshape(B, nb, Q_BLOCK, *a.shape[2:]).swapaxes(0, 1) for a in queries)
    starts = jnp.arange(nb, dtype=jnp.int32) * Q_BLOCK
    out = lax.map(lambda xs: block_fn(xs[0], *xs[1]), (starts, blocked))
    return out.swapaxes(0, 1).reshape(B, S, *out.shape[3:])


def stick_breaking_mixer(h, w_qkv, w_o):
    B, S, _ = h.shape
    qkv = h @ w_qkv
    q, k, v = [a.reshape(B, S, SB_HEADS, SB_HEAD_DIM) for a in jnp.split(qkv, 3, axis=-1)]
    key_idx = jnp.arange(S)
    scale = SB_HEAD_DIM ** -0.5

    def block(q0, qb):
        z = jnp.einsum('bqhd,bkhd->bhqk', qb, k).astype(jnp.float32) * scale
        t = q0 + jnp.arange(Q_BLOCK)
        mask = key_idx[None, :] < t[:, None]
        log_one_minus = jnp.where(mask, -jax.nn.softplus(z), 0.0)
        after = lax.cumsum(log_one_minus, axis=3, reverse=True) - log_one_minus
        A = jnp.where(mask, jnp.exp(jax.nn.log_sigmoid(z) + after), 0.0)
        return jnp.einsum('bhqk,bkhd->bqhd', A.astype(v.dtype), v)

    o = _sweep_query_blocks(block, (q,))
    return o.reshape(B, S, SB_HEADS * SB_HEAD_DIM) @ w_o


def hgrn2_mixer(h, w_in, g_norm, w_o, lb):
    B, S, _ = h.shape
    N = S // CHUNK
    proj = h @ w_in
    q, fz, i, g = jnp.split(proj, [HG_WIDTH, 2 * HG_WIDTH, 2 * HG_WIDTH + HG_HEADS * HG_VAL_DIM], axis=-1)
    fz = fz.astype(jnp.float32)
    log_f = jnp.logaddexp(jnp.log(lb), jnp.log1p(-lb) + jax.nn.log_sigmoid(fz))
    k = (1.0 - lb) * jax.nn.sigmoid(-fz)

    def to_chunks(a, d):
        return a.astype(jnp.float32).reshape(B, N, CHUNK, HG_HEADS, d).transpose(1, 0, 3, 2, 4)

    xs = (to_chunks(q, HG_KEY_DIM), to_chunks(k, HG_KEY_DIM),
          to_chunks(i, HG_VAL_DIM), to_chunks(log_f, HG_KEY_DIM))
    causal = jnp.tril(jnp.ones((CHUNK, CHUNK), dtype=bool))[None, None, :, :, None]

    def step(state, chunk):
        qc, kc, vc, lfc = chunk
        b = jnp.cumsum(lfc, axis=2)
        b_last = b[:, :, -1:, :]
        o_inter = jnp.einsum('bhtc,bhcv->bhtv', qc * jnp.exp(b), state)
        diff = jnp.where(causal, b[:, :, :, None, :] - b[:, :, None, :, :], -jnp.inf)
        scores = jnp.einsum('bhtc,bhsc,bhtsc->bhts', qc, kc, jnp.exp(diff))
        o_intra = jnp.einsum('bhts,bhsv->bhtv', scores, vc)
        new_state = (jnp.exp(b_last[:, :, 0, :])[..., None] * state
                     + jnp.einsum('bhsc,bhsv->bhcv', kc * jnp.exp(b_last - b), vc))
        return new_state, o_inter + o_intra

    state0 = jnp.zeros((B, HG_HEADS, HG_KEY_DIM, HG_VAL_DIM), jnp.float32)
    _, o = lax.scan(step, state0, xs)
    o = o.transpose(1, 0, 3, 2, 4).reshape(B, S, HG_HEADS, HG_VAL_DIM)
    o = o * lax.rsqrt(jnp.mean(o * o, axis=-1, keepdims=True) + RMS_EPS) * g_norm.astype(jnp.float32)
    o = o.reshape(B, S, HG_HEADS * HG_VAL_DIM) * jax.nn.silu(g.astype(jnp.float32))
    return o.astype(h.dtype) @ w_o


def _rope_cos_sin(positions):
    inv_freq = ROPE_THETA ** (-jnp.arange(0, MLA_ROPE, 2, dtype=jnp.float32) / MLA_ROPE)
    ang = positions.astype(jnp.float32)[..., None] * inv_freq
    return jnp.cos(ang), jnp.sin(ang)


def _apply_rope(x, cos, sin):
    x1, x2 = jnp.split(x.astype(jnp.float32), 2, axis=-1)
    return jnp.concatenate([x1 * cos - x2 * sin, x1 * sin + x2 * cos], axis=-1).astype(x.dtype)


def mla_mixer(h, positions, w_dkv, q_norm, kv_norm, w_uq, w_ukv, w_o):
    B, S, _ = h.shape
    c_q, c_kv, k_pe = jnp.split(h @ w_dkv, [MLA_Q_RANK, MLA_Q_RANK + MLA_KV_RANK], axis=-1)
    c_q = rms_norm(c_q, q_norm)
    c_kv = rms_norm(c_kv, kv_norm)
    q = (c_q @ w_uq).reshape(B, S, MLA_HEADS, MLA_NOPE + MLA_ROPE)
    q_nope, q_pe = q[..., :MLA_NOPE], q[..., MLA_NOPE:]
    kv = (c_kv @ w_ukv).reshape(B, S, MLA_HEADS, MLA_NOPE + MLA_V)
    k_nope, v = kv[..., :MLA_NOPE], kv[..., MLA_NOPE:]
    cos, sin = _rope_cos_sin(positions)
    q_pe = _apply_rope(q_pe, cos[:, :, None, :], sin[:, :, None, :])
    k_pe = _apply_rope(k_pe, cos, sin)
    key_chunk = jnp.arange(S) // CHUNK
    scale = (MLA_NOPE + MLA_ROPE) ** -0.5

    def block(q0, qn, qp):
        s = (jnp.einsum('bqhd,bkhd->bhqk', qn, k_nope)
             + jnp.einsum('bqhr,bkr->bhqk', qp, k_pe)).astype(jnp.float32) * scale
        q_chunk = (q0 + jnp.arange(Q_BLOCK)) // CHUNK
        mask = key_chunk[None, :] <= q_chunk[:, None]
        p = jax.nn.softmax(jnp.where(mask, s, -jnp.inf), axis=-1)
        return jnp.einsum('bhqk,bkhd->bqhd', p.astype(v.dtype), v)

    o = _sweep_query_blocks(block, (q_nope, q_pe))
    return o.reshape(B, S, MLA_HEADS * MLA_V) @ w_o


def sq_relu_mlp(h, w1, w2):
    return jnp.square(jax.nn.relu(h @ w1)) @ w2


def setup_inputs(seed: int = 0) -> dict:
    key = jax.random.key(seed)
    ks = jax.random.split(key, 20)
    n_sb, n_hg, n_mla = _n_layers_of(0), _n_layers_of(1), _n_layers_of(2)

    def w(k, shape, fan_in):
        return jax.random.normal(k, shape, jnp.float32) * (fan_in ** -0.5)

    def gain(k, shape):
        return 1.0 + 0.02 * jax.random.normal(k, shape, jnp.float32)

    return {
        "x": jax.random.normal(ks[0], (BATCH, SEQ, D_MODEL), jnp.float32),
        "positions": jnp.broadcast_to(jnp.arange(SEQ, dtype=jnp.int32), (BATCH, SEQ)),
        "norm_mix": gain(ks[1], (DEPTH, D_MODEL)),
        "norm_mlp": gain(ks[2], (DEPTH, D_MODEL)),
        "final_norm": gain(ks[3], (D_MODEL,)),
        "sb_w_qkv": w(ks[4], (n_sb, D_MODEL, 3 * SB_HEADS * SB_HEAD_DIM), D_MODEL),
        "sb_w_o": w(ks[5], (n_sb, SB_HEADS * SB_HEAD_DIM, D_MODEL), SB_HEADS * SB_HEAD_DIM),
        "hg_w_in": w(ks[6], (n_hg, D_MODEL, 3 * HG_WIDTH + HG_HEADS * HG_VAL_DIM), D_MODEL),
        "hg_lb_logits": 0.5 * jax.random.normal(ks[7], (DEPTH, HG_WIDTH), jnp.float32),
        "hg_g_norm": gain(ks[8], (n_hg, HG_VAL_DIM)),
        "hg_w_o": w(ks[9], (n_hg, HG_HEADS * HG_VAL_DIM, D_MODEL), HG_HEADS * HG_VAL_DIM),
        "mla_w_dkv": w(ks[10], (n_mla, D_MODEL, MLA_Q_RANK + MLA_KV_RANK + MLA_ROPE), D_MODEL),
        "mla_q_norm": gain(ks[11], (n_mla, MLA_Q_RANK)),
        "mla_kv_norm": gain(ks[12], (n_mla, MLA_KV_RANK)),
        "mla_w_uq": w(ks[13], (n_mla, MLA_Q_RANK, MLA_HEADS * (MLA_NOPE + MLA_ROPE)), MLA_Q_RANK),
        "mla_w_ukv": w(ks[14], (n_mla, MLA_KV_RANK, MLA_HEADS * (MLA_NOPE + MLA_V)), MLA_KV_RANK),
        "mla_w_o": w(ks[15], (n_mla, MLA_HEADS * MLA_V, D_MODEL), MLA_HEADS * MLA_V),
        "mlp_w1": w(ks[16], (DEPTH, D_MODEL, D_FF), D_MODEL),
        "mlp_w2": w(ks[17], (DEPTH, D_FF, D_MODEL), D_FF),
    }


def reference(x, positions, norm_mix, norm_mlp, final_norm, sb_w_qkv, sb_w_o, hg_w_in,
              hg_lb_logits, hg_g_norm, hg_w_o, mla_w_dkv, mla_q_norm, mla_kv_norm,
              mla_w_uq, mla_w_ukv, mla_w_o, mlp_w1, mlp_w2):
    p_lb = jax.nn.softmax(hg_lb_logits.astype(jnp.float32), axis=0)
    lb_all = jnp.cumsum(p_lb, axis=0) - p_lb[0]
    h = x
    for i in range(DEPTH):
        m, j = i % N_MIXERS, i // N_MIXERS
        a = rms_norm(h, norm_mix[i])
        if m == 0:
            y = stick_breaking_mixer(a, sb_w_qkv[j], sb_w_o[j])
        elif m == 1:
            y = hgrn2_mixer(a, hg_w_in[j], hg_g_norm[j], hg_w_o[j], lb_all[i])
        else:
            y = mla_mixer(a, positions, mla_w_dkv[j], mla_q_norm[j], mla_kv_norm[j],
                          mla_w_uq[j], mla_w_ukv[j], mla_w_o[j])
        h = h + y
        h = h + sq_relu_mlp(rms_norm(h, norm_mlp[i]), mlp_w1[i], mlp_w2[i])
    return rms_norm(h, final_norm)
```

```cpp
#include <hip/hip_runtime.h>
#include <cstdio>
#include <cstdint>

constexpr int NWAVES = 8;
constexpr int BATCH = 2, SEQ = 8192, DM = 2048, DEPTH = 4, M = BATCH * SEQ;
constexpr int NH = 16, HD = 128, DFF = 8192;
constexpr int MLA_QR = 768, MLA_KVR = 512, MLA_ROPE = 64, MLA_NOPE = 128, MLA_QK = 192, MLA_DKV_N = 1344, MLA_DKV_NP = 2048;
constexpr int CHUNK = 64, NCHUNK = SEQ / CHUNK;
constexpr float RMS_EPS = 1e-6f;
constexpr float LOG2E = 1.4426950408889634f;

constexpr size_t MiB = 1u << 20;
constexpr size_t WS_CTL = 0, CTL_ZERO_BYTES = 2 * MiB;
constexpr int CW_TMO = 0, CW_BAR = 4096;
constexpr size_t CTL_ROWSS = 256 * 1024;
constexpr int RS_Q = 9, RS_KV = 10;
constexpr size_t WS_TAB = 2 * MiB;
constexpr size_t WS_CS = 3 * MiB;
constexpr size_t WS_W = 7 * MiB;
constexpr size_t W_SBQKV = WS_W;
constexpr size_t W_SBWO = W_SBQKV + 2 * (size_t)6144 * 2048 * 2;
constexpr size_t W_HGIN = W_SBWO + 2 * (size_t)2048 * 2048 * 2;
constexpr size_t W_HGWO = W_HGIN + (size_t)8192 * 2048 * 2;
constexpr size_t W_DKV = W_HGWO + (size_t)2048 * 2048 * 2;
constexpr size_t W_UQ = W_DKV + (size_t)2048 * 2048 * 2;
constexpr size_t W_UKV = W_UQ + (size_t)3072 * 768 * 2;
constexpr size_t W_MLAWO = W_UKV + (size_t)4096 * 512 * 2;
constexpr size_t W_W1 = W_MLAWO + (size_t)2048 * 2048 * 2;
constexpr size_t W_W2 = W_W1 + 4 * (size_t)8192 * 2048 * 2;
constexpr size_t W_END = W_W2 + 4 * (size_t)8192 * 2048 * 2;
constexpr size_t WS_AB = 392 * MiB;
constexpr size_t WS_OB = WS_AB + 64 * MiB;
constexpr size_t WS_BIG = WS_OB + 64 * MiB;
static_assert(W_END <= WS_AB, "weights fit");
constexpr size_t BIG_QKV = 0;
constexpr size_t BIG_HID = 0;
constexpr size_t BIG_HQ = 0, BIG_HI = 64 * MiB, BIG_HG = 128 * MiB, BIG_HLF = 192 * MiB, BIG_HKVS = 320 * MiB;
constexpr size_t BIG_HDEC = 448 * MiB;
constexpr size_t BIG_CQ = 0, BIG_CKV = 24 * MiB, BIG_KPE = 40 * MiB, BIG_QM = 48 * MiB, BIG_KVM = 144 * MiB;
constexpr size_t WS_END = WS_BIG + 452 * MiB;
static_assert(WS_END <= (size_t)1024 * MiB, "workspace map inside 1 GiB");

constexpr int RING_OFF = 0, RING_BYTES = 131072;
constexpr int LDSCTL_OFF = RING_BYTES, MISC_OFF = LDSCTL_OFF + 320;
constexpr int LDS_BYTES = 147456;

namespace pg8 {
#define PG8_LAS __attribute__((address_space(3)))
typedef unsigned short bf16_t;
typedef short bf16x8 __attribute__((ext_vector_type(8)));
typedef float f32x4 __attribute__((ext_vector_type(4)));
typedef unsigned u32x4 __attribute__((ext_vector_type(4)));
constexpr int BM = 256, BK = 64, HALF = 128, HTB = HALF * BK * 2  , STAGE_BYTES = 8 * HTB, NXCD = 8;

__host__ __device__ __forceinline__ int lds_byte(int r, int c) { const int st = (r >> 4) * 2 + (c >> 5), rr = r & 15, cc = c & 31, ob = rr * 64 + cc * 2; return st * 1024 + (ob ^ (((ob >> 9) & 1) << 5)); }
__host__ __device__ __forceinline__ void stage_rc(int b, int& R, int& C) { const int st = b / 1024, sb = b % 1024, swz = sb ^ (((sb >> 9) & 1) << 5); R = (st >> 1) * 16 + swz / 64; C = (st & 1) * 32 + (swz % 64) / 2; }
__host__ __device__ __forceinline__ int perm32(int rho) { const int n = rho >> 4, i = rho & 15; return 8 * (i >> 2) + 4 * n + (i & 3); }

struct Unit { int pm, pn; };
struct Gemm { const bf16_t* A; const bf16_t* Bt; int M, N, K; };

struct StaticOrder {
    int nM, nN, nwg, G, c, WGM, rev;
    __host__ __device__ void init(int M, int N, int G_, int c_, int wgm = 4, int rev_ = 0) { nM = M / BM; nN = N / BM; nwg = nM * nN; G = G_; c = c_; WGM = wgm; rev = rev_; }
    __host__ __device__ bool next(int i, Unit& u) const {
        const long L = (long)i * G + c; if (L >= nwg) return false;
        int wgid = (int)L; { const int q = nwg / NXCD, r = nwg % NXCD, xcd = wgid % NXCD, off = wgid / NXCD; wgid = (xcd < r ? xcd * (q + 1) : r * (q + 1) + (xcd - r) * q) + off; }
        const int nig = WGM * nN, gid = wgid / nig, fm = gid * WGM, gsz = (nM - fm) < WGM ? (nM - fm) : WGM;
        u.pm = fm + ((wgid % nig) % gsz); u.pn = (wgid % nig) / gsz; if (rev) u.pm = nM - 1 - u.pm; return true;
    }
    __device__ __forceinline__ void a_ready(const Unit&) const {}
    __device__ __forceinline__ void done(const Unit&) const {}
};
__device__ __forceinline__ unsigned cvt_pk_bf16(float lo, float hi) { unsigned r; asm volatile("v_cvt_pk_bf16_f32 %0, %1, %2" : "=v"(r) : "v"(lo), "v"(hi)); return r; }
constexpr size_t KWS_AB = WS_AB, KCTL_ROWSS = WS_CTL + CTL_ROWSS, KWS_BIG = WS_BIG, KWS_CS = WS_CS, KWS_TAB = WS_TAB, KM = M;
constexpr size_t KBIG_QKV = BIG_QKV, KBIG_HID = BIG_HID, KBIG_HQ = BIG_HQ, KBIG_HI = BIG_HI, KBIG_HG = BIG_HG, KBIG_HLF = BIG_HLF, KBIG_CQ = BIG_CQ, KBIG_CKV = BIG_CKV, KBIG_KPE = BIG_KPE, KBIG_QM = BIG_QM, KBIG_KVM = BIG_KVM;
__device__ __forceinline__ u32x4 pack8_bf16(const f32x4 a, const f32x4 b) { u32x4 w; w.x = cvt_pk_bf16(a[0], a[1]); w.y = cvt_pk_bf16(a[2], a[3]); w.z = cvt_pk_bf16(b[0], b[1]); w.w = cvt_pk_bf16(b[2], b[3]); return w; }
__device__ __forceinline__ float dot4(const f32x4 a) { return (a[0] * a[0] + a[1] * a[1]) + (a[2] * a[2] + a[3] * a[3]); }
typedef unsigned long long u64;
constexpr double RSS_FIX = 16777216.0;
__device__ __forceinline__ void rowss_add(u64* p, float v) {
    const float hf = floorf(v * 0.00390625f); const float rem = fmaf(-256.0f, hf, v);
    const u64 q = ((u64)(unsigned)hf << 32) | (u64)(unsigned)(rem * 16777216.0f);
    const u64 old = __hip_atomic_fetch_add(p, q, __ATOMIC_RELAXED, __HIP_MEMORY_SCOPE_AGENT);
    asm volatile("" :: "v"(old));
}
__device__ __forceinline__ float rowss_cvt(u64 v) { return (float)((double)(long long)v * (1.0 / RSS_FIX)); }
__device__ __forceinline__ float rowss_get(const u64* p) { return rowss_cvt(*p); }
__device__ __forceinline__ float rowss_rs(u64 v, float inv_k) { const float f = (float)(unsigned)(v >> 32) * 256.0f + (float)(unsigned)v * (float)(1.0 / RSS_FIX); return __builtin_amdgcn_rsqf(f * inv_k + 1e-6f); }

__device__ __forceinline__ float quad16_sum(float v) {
    { const unsigned u = __builtin_bit_cast(unsigned, v); auto r = __builtin_amdgcn_permlane16_swap(u, u, false, false); v = __builtin_bit_cast(float, (unsigned)r[0]) + __builtin_bit_cast(float, (unsigned)r[1]); }
    { const unsigned u = __builtin_bit_cast(unsigned, v); auto r = __builtin_amdgcn_permlane32_swap(u, u, false, false); v = __builtin_bit_cast(float, (unsigned)r[0]) + __builtin_bit_cast(float, (unsigned)r[1]); }
    return v;
}
__device__ __forceinline__ f32x4 bf16x4_lo(const u32x4 w, int half) { f32x4 r; const unsigned a = half ? w.z : w.x, b = half ? w.w : w.y;
    r[0] = __builtin_bit_cast(float, a << 16); r[1] = __builtin_bit_cast(float, a & 0xffff0000u); r[2] = __builtin_bit_cast(float, b << 16); r[3] = __builtin_bit_cast(float, b & 0xffff0000u); return r; }
struct EpiResid {
    static constexpr bool PERM = true, AFTER_DRAIN = false;
    const float* x0; unsigned char* ws; int rs_idx;
    struct Pref {};
    __device__ __forceinline__ void prefetch(const Unit&, int, int, Pref&) const {}
    __device__ __forceinline__ void operator()(const f32x4 (&acc)[2][2][4][2], const Unit& u, int wr, int wc, int fr, int fq, const Pref&) const {
        const int row0 = u.pm * BM + wr * 64 + fr, col0 = u.pn * BM + wc * 32 + 8 * fq;
        bf16_t* ab = (bf16_t*)(ws + KWS_AB); u64* rowss = (u64*)(ws + KCTL_ROWSS) + (size_t)rs_idx * KM;
        if (x0) {
#pragma unroll
            for (int ai = 0; ai < 2; ++ai) {
                f32x4 r[4][2][2];
#pragma unroll
                for (int m = 0; m < 4; ++m)
#pragma unroll
                    for (int bj = 0; bj < 2; ++bj) { const float* p = x0 + (size_t)(row0 + ai * HALF + m * 16) * 2048 + col0 + bj * HALF; r[m][bj][0] = *(const f32x4*)p; r[m][bj][1] = *(const f32x4*)(p + 4); }
#pragma unroll
                for (int m = 0; m < 4; ++m) {
                    const int row = row0 + ai * HALF + m * 16; const size_t off = (size_t)row * 2048 + col0; float ss = 0.f;
#pragma unroll
                    for (int bj = 0; bj < 2; ++bj) {
                        const f32x4 v0 = r[m][bj][0] + acc[ai][bj][m][0], v1 = r[m][bj][1] + acc[ai][bj][m][1];
                        ss += dot4(v0) + dot4(v1);
                        *(u32x4*)(ab + off + bj * HALF) = pack8_bf16(v0, v1);
                    }
                    ss = quad16_sum(ss);
                    if (fq == 0) rowss_add(rowss + row, ss);
                }
                asm volatile("" ::: "memory");
            }
        } else {
            u32x4 w[2][4][2];
#pragma unroll
            for (int ai = 0; ai < 2; ++ai)
#pragma unroll
                for (int m = 0; m < 4; ++m)
#pragma unroll
                    for (int bj = 0; bj < 2; ++bj) w[ai][m][bj] = *(const u32x4*)(ab + (size_t)(row0 + ai * HALF + m * 16) * 2048 + col0 + bj * HALF);
#pragma unroll
            for (int ai = 0; ai < 2; ++ai)
#pragma unroll
                for (int m = 0; m < 4; ++m) {
                    const int row = row0 + ai * HALF + m * 16; const size_t off = (size_t)row * 2048 + col0; float ss = 0.f;
#pragma unroll
                    for (int bj = 0; bj < 2; ++bj) {
                        const f32x4 v0 = bf16x4_lo(w[ai][m][bj], 0) + acc[ai][bj][m][0], v1 = bf16x4_lo(w[ai][m][bj], 1) + acc[ai][bj][m][1];
                        ss += dot4(v0) + dot4(v1);
                        *(u32x4*)(ab + off + bj * HALF) = pack8_bf16(v0, v1);
                    }
                    ss = quad16_sum(ss);
                    if (fq == 0) rowss_add(rowss + row, ss);
                }
        }
    }
};

enum { EM_SBQKV = 0, EM_RELU2 = 1, EM_HG = 2, EM_DKV = 3, EM_UQ = 4, EM_UKV = 5 };
struct EpiMulti {
    static constexpr bool PERM = true, AFTER_DRAIN = false;
    int mode, rs_idx; float inv_k, qscale; unsigned char* ws;
    struct Pref { u64 v[2][4]; };
    __device__ __forceinline__ void prefetch(const Unit& u, int wr, int fr, Pref& p) const {
        const u64* r = (const u64*)(ws + KCTL_ROWSS) + (size_t)rs_idx * KM + u.pm * BM + wr * 64 + fr;
#pragma unroll
        for (int ai = 0; ai < 2; ++ai)
#pragma unroll
            for (int m = 0; m < 4; ++m) p.v[ai][m] = r[ai * HALF + m * 16];
    }
    __device__ __forceinline__ void operator()(const f32x4 (&acc)[2][2][4][2], const Unit& u, int wr, int wc, int fr, int fq, const Pref& pf) const {
        const int row0 = u.pm * BM + wr * 64 + fr, colt = u.pn * BM, lc = wc * 32 + 8 * fq;
        unsigned char* big = ws + KWS_BIG; const float* cs = (const float*)(ws + KWS_CS);
#pragma unroll
        for (int ai = 0; ai < 2; ++ai)
#pragma unroll
            for (int m = 0; m < 4; ++m) {
                const int row = row0 + ai * HALF + m * 16;
                const float rs = rowss_rs(pf.v[ai][m], inv_k);
                float ss = 0.f;
#pragma unroll
                for (int bj = 0; bj < 2; ++bj) {
                    f32x4 v0 = acc[ai][bj][m][0] * rs, v1 = acc[ai][bj][m][1] * rs;
                    const int col = colt + bj * HALF + lc;
                    if (mode == EM_SBQKV) {
                        if (col < 2048) { v0 = v0 * qscale; v1 = v1 * qscale; }
                        *(u32x4*)((bf16_t*)(big + KBIG_QKV) + (size_t)row * 6144 + col) = pack8_bf16(v0, v1);
                    } else if (mode == EM_RELU2) {
#pragma unroll
                        for (int e = 0; e < 4; ++e) { v0[e] = fmaxf(v0[e], 0.f); v1[e] = fmaxf(v1[e], 0.f); }
                        v0 = v0 * v0; v1 = v1 * v1;
                        *(u32x4*)((bf16_t*)(big + KBIG_HID) + (size_t)row * 8192 + col) = pack8_bf16(v0, v1);
                    } else if (mode == EM_HG) {
                        const int t = col >> 11, c = col & 2047;
                        if (t == 1) {
                            const float* lbt = (const float*)(ws + KWS_TAB) + 4096; const float* omlt = lbt + 2048;
                            const f32x4 la0 = *(const f32x4*)(lbt + c), la1 = *(const f32x4*)(lbt + c + 4), lm0 = *(const f32x4*)(omlt + c), lm1 = *(const f32x4*)(omlt + c + 4);
                            f32x4 o0, o1;
#pragma unroll
                            for (int e = 0; e < 4; ++e) {
                                o0[e] = __logf(fmaf(lm0[e], __builtin_amdgcn_rcpf(1.f + __expf(-v0[e])), la0[e]));
                                o1[e] = __logf(fmaf(lm1[e], __builtin_amdgcn_rcpf(1.f + __expf(-v1[e])), la1[e]));
                            }
                            float* lf = (float*)(big + KBIG_HLF); *(f32x4*)(lf + (size_t)row * 2048 + c) = o0; *(f32x4*)(lf + (size_t)row * 2048 + c + 4) = o1;
                        } else {
                            bf16_t* dst = (bf16_t*)(big + ((t == 0) ? KBIG_HQ : (t == 2) ? KBIG_HI : KBIG_HG));
                            *(u32x4*)(dst + (size_t)row * 2048 + c) = pack8_bf16(v0, v1);
                        }
                    } else if (mode == EM_DKV) {
                        if (col < 768) { ss += dot4(v0) + dot4(v1); *(u32x4*)((bf16_t*)(big + KBIG_CQ) + (size_t)row * 768 + col) = pack8_bf16(v0, v1); }
                        else if (col < 1280) { ss += dot4(v0) + dot4(v1); *(u32x4*)((bf16_t*)(big + KBIG_CKV) + (size_t)row * 512 + (col - 768)) = pack8_bf16(v0, v1); }
                        else if (col < 1344) {
                            const int i0 = (col - 1280) >> 1;
                            const f32x4 c0 = *(const f32x4*)(cs + (size_t)row * 64 + 2 * i0), c1 = *(const f32x4*)(cs + (size_t)row * 64 + 2 * i0 + 4);
                            f32x4 o0, o1;
                            o0[0] = v0[0] * c0[0] - v0[1] * c0[1]; o0[1] = v0[0] * c0[1] + v0[1] * c0[0]; o0[2] = v0[2] * c0[2] - v0[3] * c0[3]; o0[3] = v0[2] * c0[3] + v0[3] * c0[2];
                            o1[0] = v1[0] * c1[0] - v1[1] * c1[1]; o1[1] = v1[0] * c1[1] + v1[1] * c1[0]; o1[2] = v1[2] * c1[2] - v1[3] * c1[3]; o1[3] = v1[2] * c1[3] + v1[3] * c1[2];
                            *(u32x4*)((bf16_t*)(big + KBIG_KPE) + (size_t)row * 64 + (col - 1280)) = pack8_bf16(o0, o1);
                        }
                    } else if (mode == EM_UQ) {
                        v0 = v0 * qscale; v1 = v1 * qscale;
                        const int cc = col % 192;
                        if (cc >= 128) {
                            const int i0 = (cc - 128) >> 1;
                            const f32x4 c0 = *(const f32x4*)(cs + (size_t)row * 64 + 2 * i0), c1 = *(const f32x4*)(cs + (size_t)row * 64 + 2 * i0 + 4);
                            f32x4 o0, o1;
                            o0[0] = v0[0] * c0[0] - v0[1] * c0[1]; o0[1] = v0[0] * c0[1] + v0[1] * c0[0]; o0[2] = v0[2] * c0[2] - v0[3] * c0[3]; o0[3] = v0[2] * c0[3] + v0[3] * c0[2];
                            o1[0] = v1[0] * c1[0] - v1[1] * c1[1]; o1[1] = v1[0] * c1[1] + v1[1] * c1[0]; o1[2] = v1[2] * c1[2] - v1[3] * c1[3]; o1[3] = v1[2] * c1[3] + v1[3] * c1[2];
                            v0 = o0; v1 = o1;
                        }
                        *(u32x4*)((bf16_t*)(big + KBIG_QM) + (size_t)row * 3072 + col) = pack8_bf16(v0, v1);
                    } else {
                        *(u32x4*)((bf16_t*)(big + KBIG_KVM) + (size_t)row * 4096 + col) = pack8_bf16(v0, v1);
                    }
                }
                if (mode == EM_DKV && colt < 1280) {
                    ss = quad16_sum(ss);
                    if (fq == 0) rowss_add((u64*)(ws + KCTL_ROWSS) + (size_t)(colt < 768 ? 9 : 10) * KM + row, ss);
                }
                if (m & 1) asm volatile("" ::: "memory");
            }
    }
};
template <class Epi, class Sched, bool ALIGN_EPI = false, bool SP2 = false>
__device__ __forceinline__ void gemm_phase(PG8_LAS unsigned char* lds, const Gemm g, const Sched& S, const Epi& E) {
    int tid_ = threadIdx.x; asm volatile("" : "+v"(tid_));
    const int tid = tid_, wid = __builtin_amdgcn_readfirstlane(tid >> 6), lane = tid & 63, wr = wid >> 2, wc = wid & 3, fr = lane & 15, fq = lane >> 4;
    const int K = g.K, nt = K / BK;
    unsigned voffA[2], voffB[2];
#pragma unroll
    for (int i = 0; i < 2; ++i) { int R, C; stage_rc(tid * 16 + i * 8192, R, C); const int Rb = Epi::PERM ? ((R & ~31) + perm32(R & 31)) : R;
        voffA[i] = (unsigned)(R * K + C) * 2u; voffB[i] = (unsigned)(Rb * K + C) * 2u; }
    const size_t kstep = (size_t)(BK * 2);
    const size_t hstep = (size_t)HALF * K * 2;
    const size_t tstep = 2 * hstep;
    const unsigned ldsw = (unsigned)wid * 1024u;
    const int aoff = lds_byte(wr * 64 + fr, fq * 8), boff = lds_byte(wc * 32 + fr, fq * 8);
#define PG8_SA(b, h) (((b) * 2 + (h)) * HTB)
#define PG8_SB(b, h) ((4 + (b) * 2 + (h)) * HTB)
#define PG8_STAGE(bufoff, gbase, voff) do { _Pragma("unroll") for (int _i = 0; _i < 2; ++_i) \
        __builtin_amdgcn_global_load_lds((const unsigned*)((const char*)(gbase) + (voff)[_i]), (PG8_LAS unsigned*)(lds + (bufoff) + ldsw + _i * 8192), 16, 0, 0); } while (0)
#define PG8_LDA(dst, b, h) do { _Pragma("unroll") for (int m = 0; m < 4; ++m) _Pragma("unroll") for (int k = 0; k < 2; ++k) dst[m][k] = *(const PG8_LAS bf16x8*)(lds + PG8_SA(b, h) + aoff + m * 2048 + k * 1024); } while (0)
#define PG8_LDB(dst, b, h) do { _Pragma("unroll") for (int n = 0; n < 2; ++n) _Pragma("unroll") for (int k = 0; k < 2; ++k) dst[n][k] = *(const PG8_LAS bf16x8*)(lds + PG8_SB(b, h) + boff + n * 2048 + k * 1024); } while (0)
#define PG8_MMA(ai, bj, At, Bt) do { __builtin_amdgcn_s_setprio(1); _Pragma("unroll") for (int m = 0; m < 4; ++m) _Pragma("unroll") for (int n = 0; n < 2; ++n) _Pragma("unroll") for (int k = 0; k < 2; ++k) \
        acc[ai][bj][m][n] = __builtin_amdgcn_mfma_f32_16x16x32_bf16(Bt[n][k], At[m][k], acc[ai][bj][m][n], 0, 0, 0); __builtin_amdgcn_s_setprio(0); } while (0)
#define PG8_WAIT_V(n) asm volatile("s_waitcnt vmcnt(" #n ")" ::: "memory")
#define PG8_WAIT_L(n) asm volatile("s_waitcnt lgkmcnt(" #n ")" ::: "memory")
#define PG8_BAR __builtin_amdgcn_s_barrier()
#define PG8_SCHED __builtin_amdgcn_sched_barrier(0)
    Unit cur, nxt; int ui = 0;
    if (!S.next(0, cur)) return;
    f32x4 acc[2][2][4][2];
#pragma unroll
    for (int a = 0; a < 2; ++a)
#pragma unroll
        for (int b = 0; b < 2; ++b)
#pragma unroll
            for (int m = 0; m < 4; ++m)
#pragma unroll
                for (int n = 0; n < 2; ++n) acc[a][b][m][n] = (f32x4){0.f, 0.f, 0.f, 0.f};
    bf16x8 At[4][2], B0[2][2], B1[2][2];
    const char* cA = (const char*)g.A + (size_t)cur.pm * tstep; const char* cB = (const char*)g.Bt + (size_t)cur.pn * tstep;
    S.a_ready(cur);
    typename Epi::Pref pf; E.prefetch(cur, wr, fr, pf);
    if constexpr (SP2) {
        PG8_STAGE(PG8_SB(0, 0), cB, voffB); PG8_STAGE(PG8_SB(0, 1), cB + hstep, voffB); PG8_STAGE(PG8_SA(0, 0), cA, voffA); PG8_STAGE(PG8_SA(0, 1), cA + hstep, voffA);
        if (wr == 1) PG8_BAR;
        PG8_WAIT_V(2); PG8_BAR;
        PG8_STAGE(PG8_SB(1, 0), cB + kstep, voffB); PG8_STAGE(PG8_SA(1, 0), cA + kstep, voffA); PG8_STAGE(PG8_SB(1, 1), cB + hstep + kstep, voffB);
        PG8_WAIT_V(6); PG8_BAR;
    } else {
        PG8_STAGE(PG8_SB(0, 0), cB, voffB); PG8_STAGE(PG8_SA(0, 0), cA, voffA); PG8_STAGE(PG8_SB(0, 1), cB + hstep, voffB); PG8_STAGE(PG8_SA(0, 1), cA + hstep, voffA);
        if (wr == 1) PG8_BAR;
        PG8_WAIT_V(4); PG8_BAR;
        PG8_STAGE(PG8_SB(1, 0), cB + kstep, voffB); PG8_STAGE(PG8_SA(1, 0), cA + kstep, voffA); PG8_STAGE(PG8_SB(1, 1), cB + hstep + kstep, voffB);
        PG8_WAIT_V(6); PG8_BAR;
    }
    for (;;) {
        const bool has_next = S.next(ui + 1, nxt);
        const char* nA = has_next ? (const char*)g.A + (size_t)nxt.pm * tstep : cA; const char* nB = has_next ? (const char*)g.Bt + (size_t)nxt.pn * tstep : cB;
        for (int t = 0; t < nt; t += 2) {
            const bool last = (t == nt - 2);
            const char* a1 = cA + (size_t)(t + 1) * kstep;
            const char* a2 = last ? nA : cA + (size_t)(t + 2) * kstep; const char* b2 = last ? nB : cB + (size_t)(t + 2) * kstep;
            const char* a3 = a2 + kstep; const char* b3 = b2 + kstep;
            if (last && has_next) S.a_ready(nxt);
            if constexpr (SP2) {
            PG8_LDB(B0, 0, 0); PG8_LDB(B1, 0, 1); PG8_SCHED; PG8_LDA(At, 0, 0); PG8_STAGE(PG8_SA(1, 1), a1 + hstep, voffA);
            PG8_WAIT_V(8); PG8_WAIT_L(0); PG8_BAR; PG8_MMA(0, 0, At, B0); PG8_MMA(0, 1, At, B1); PG8_BAR; PG8_SCHED;
            PG8_LDA(At, 0, 1); PG8_STAGE(PG8_SB(0, 0), b2, voffB); PG8_STAGE(PG8_SB(0, 1), b2 + hstep, voffB); PG8_STAGE(PG8_SA(0, 0), a2, voffA);
            PG8_WAIT_V(8); PG8_WAIT_L(0); PG8_BAR; PG8_MMA(1, 0, At, B0); PG8_MMA(1, 1, At, B1); PG8_BAR; PG8_SCHED;
            PG8_LDB(B0, 1, 0); PG8_LDB(B1, 1, 1); PG8_SCHED; PG8_LDA(At, 1, 0); PG8_STAGE(PG8_SA(0, 1), a2 + hstep, voffA);
            PG8_WAIT_V(8); PG8_WAIT_L(0); PG8_BAR; PG8_MMA(0, 0, At, B0); PG8_MMA(0, 1, At, B1); PG8_BAR; PG8_SCHED;
            PG8_LDA(At, 1, 1); PG8_STAGE(PG8_SB(1, 0), b3, voffB); PG8_STAGE(PG8_SB(1, 1), b3 + hstep, voffB); PG8_STAGE(PG8_SA(1, 0), a3, voffA);
            PG8_WAIT_V(8); PG8_WAIT_L(0); PG8_BAR; PG8_MMA(1, 0, At, B0); PG8_MMA(1, 1, At, B1); PG8_BAR; PG8_SCHED;
            } else {
            PG8_LDB(B0, 0, 0); PG8_SCHED; PG8_LDA(At, 0, 0); PG8_STAGE(PG8_SA(1, 1), a1 + hstep, voffA);
            PG8_WAIT_L(8); PG8_BAR; PG8_WAIT_L(0); PG8_MMA(0, 0, At, B0); PG8_BAR; PG8_SCHED;
            PG8_LDB(B1, 0, 1); PG8_STAGE(PG8_SB(0, 0), b2, voffB);
            PG8_BAR; PG8_WAIT_L(0); PG8_MMA(0, 1, At, B1); PG8_BAR;
            PG8_LDA(At, 0, 1); PG8_STAGE(PG8_SA(0, 0), a2, voffA);
            PG8_BAR; PG8_WAIT_L(0); PG8_MMA(1, 0, At, B0); PG8_BAR; PG8_SCHED;
            PG8_STAGE(PG8_SB(0, 1), b2 + hstep, voffB);
            PG8_WAIT_V(6); PG8_BAR; PG8_MMA(1, 1, At, B1); PG8_BAR;
            PG8_LDB(B0, 1, 0); PG8_SCHED; PG8_LDA(At, 1, 0); PG8_STAGE(PG8_SA(0, 1), a2 + hstep, voffA);
            PG8_WAIT_L(8); PG8_BAR; PG8_WAIT_L(0); PG8_MMA(0, 0, At, B0); PG8_BAR; PG8_SCHED;
            PG8_LDB(B1, 1, 1); PG8_STAGE(PG8_SB(1, 0), b3, voffB);
            PG8_BAR; PG8_WAIT_L(0); PG8_MMA(0, 1, At, B1); PG8_BAR;
            PG8_LDA(At, 1, 1); PG8_STAGE(PG8_SA(1, 0), a3, voffA);
            PG8_BAR; PG8_WAIT_L(0); PG8_MMA(1, 0, At, B0); PG8_BAR; PG8_SCHED;
            PG8_STAGE(PG8_SB(1, 1), b3 + hstep, voffB);
            PG8_WAIT_V(6); PG8_BAR; PG8_MMA(1, 1, At, B1); PG8_BAR;
            }
        }
        if constexpr (ALIGN_EPI) { if (wr == 0) PG8_BAR; }
        if constexpr (!Epi::AFTER_DRAIN) { E(acc, cur, wr, wc, fr, fq, pf); S.done(cur); }
        if (!has_next) break;
#pragma unroll
        for (int a = 0; a < 2; ++a)
#pragma unroll
            for (int b = 0; b < 2; ++b)
#pragma unroll
                for (int m = 0; m < 4; ++m)
#pragma unroll
                    for (int n = 0; n < 2; ++n) acc[a][b][m][n] = (f32x4){0.f, 0.f, 0.f, 0.f};
        cur = nxt; cA = nA; cB = nB; ++ui;
        E.prefetch(cur, wr, fr, pf);
        if constexpr (ALIGN_EPI) { if (wr == 1) PG8_BAR; }
    }
    PG8_WAIT_V(0);
    if constexpr (!ALIGN_EPI) { if (wr == 0) PG8_BAR; }
    PG8_BAR;
    if constexpr (Epi::AFTER_DRAIN) { E.fused(acc, cur, wr, wc, fr, fq, lds, wid, lane); S.done(cur); }
#undef PG8_SA
#undef PG8_SB
#undef PG8_STAGE
#undef PG8_LDA
#undef PG8_LDB
#undef PG8_MMA
#undef PG8_WAIT_V
#undef PG8_WAIT_L
#undef PG8_BAR
#undef PG8_SCHED
}
}

#define GAS __attribute__((address_space(1)))
#define LAS __attribute__((address_space(3)))
typedef unsigned short bf16;
typedef unsigned v4u __attribute__((ext_vector_type(4)));
typedef unsigned v2u __attribute__((ext_vector_type(2)));
typedef float f32x4 __attribute__((ext_vector_type(4)));
typedef float f32x2 __attribute__((ext_vector_type(2)));
typedef short bf16x8 __attribute__((ext_vector_type(8)));
typedef GAS unsigned gu32;
#define RLX_AGENT __ATOMIC_RELAXED, __HIP_MEMORY_SCOPE_AGENT
#define LDS_WAIT() asm volatile("s_waitcnt lgkmcnt(0)" ::: "memory")
#define VM_WAIT() asm volatile("s_waitcnt vmcnt(0)" ::: "memory")
__device__ __forceinline__ unsigned pk2(float lo, float hi) { unsigned r; asm("v_cvt_pk_bf16_f32 %0, %1, %2" : "=v"(r) : "v"(lo), "v"(hi)); return r; }
__device__ __forceinline__ unsigned f2bf(float f) { return pk2(f, f) & 0xffffu; }
__device__ __forceinline__ float bf2f(unsigned short h) { return __builtin_bit_cast(float, (unsigned)h << 16); }
__device__ __forceinline__ float wave_sum(float v) {
#pragma unroll
    for (int o = 1; o < 64; o <<= 1) v += __shfl_xor(v, o);
    return v;
}
__device__ __forceinline__ float wave_max(float v) {
#pragma unroll
    for (int o = 1; o < 64; o <<= 1) v = fmaxf(v, __shfl_xor(v, o));
    return v;
}
#define XB_TMO      128
#define XB_XCNT(j)  (256  + 64 * (j))
#define XB_XSUB(j)  (1280 + 64 * (j))
#define XB_XGEN(j)  (2304 + 64 * (j))
#define XB_TOP      3328
#define XB_TOPGEN   3392
#define XCD_BAR_WORDS 3456
#define XB_SPIN_CAP (1u << 18)

__device__ __forceinline__ unsigned xb_ld(unsigned* p)              { return __hip_atomic_load(p, __ATOMIC_RELAXED, __HIP_MEMORY_SCOPE_AGENT); }
__device__ __forceinline__ unsigned xb_add(unsigned* p, unsigned v) { return __hip_atomic_fetch_add(p, v, __ATOMIC_RELAXED, __HIP_MEMORY_SCOPE_AGENT); }
__device__ __forceinline__ unsigned xb_xcc_id() { return (unsigned)__builtin_amdgcn_s_getreg((3 << 11) | 20) & 0xFu; }
#define XB_SPIN(cond, bar) do { unsigned _sp = 0; while (cond) { __builtin_amdgcn_s_sleep(1); \
    if ((++_sp & 255u) == 0u) { if (xb_ld(&(bar)[XB_TMO])) break; if (_sp > XB_SPIN_CAP) { atomicAdd(&(bar)[XB_TMO], 1u); break; } } } } while (0)

struct XcdBarrier {
    unsigned* bar; unsigned x;
    volatile LAS unsigned* st;
};

__device__ __forceinline__ XcdBarrier xcd_barrier_post(unsigned* bar, volatile LAS unsigned* st) {
    XcdBarrier b; b.bar = bar; b.x = xb_xcc_id(); b.st = st;
    if (threadIdx.x == 0) (void)xb_add(&bar[XB_XCNT(b.x)], 1u);
    return b;
}
__device__ __forceinline__ void xcd_barrier_complete(unsigned* bar, unsigned x, unsigned& nloc, unsigned& nx) {
    const unsigned G = gridDim.x * gridDim.y * gridDim.z;
    unsigned sum, cnt, mine, sp = 0u;
    for (;;) {
        sum = 0u; cnt = 0u; mine = 0u;
#pragma unroll
        for (unsigned j = 0; j < 16; ++j) { const unsigned c = xb_ld(&bar[XB_XCNT(j)]); sum += c; cnt += (c > 0u) ? 1u : 0u; mine = (j == x) ? c : mine; }
        if (sum == G) break;
        __builtin_amdgcn_s_sleep(1);
        if ((++sp & 255u) == 0u) { if (xb_ld(&bar[XB_TMO])) break; if (sp > XB_SPIN_CAP) { atomicAdd(&bar[XB_TMO], 1u); break; } }
    }
    nloc = mine > 0u ? mine : 1u; nx = cnt > 0u ? cnt : 1u;
}

__device__ __forceinline__ void xcd_barrier(const XcdBarrier& b) {
    asm volatile("s_waitcnt vmcnt(0)" ::: "memory");
    __syncthreads();
    if (threadIdx.x == 0) {
        unsigned* bar = b.bar;
        __builtin_amdgcn_s_waitcnt(0);
        unsigned nloc = b.st[0], nx = b.st[1];
        if (nloc == 0u) { xcd_barrier_complete(bar, b.x, nloc, nx); b.st[0] = nloc; b.st[1] = nx; }
        const unsigned old = xb_add(&bar[XB_XSUB(b.x)], 1u);
        const unsigned gen = old / nloc;
        if (old + 1u == (gen + 1u) * nloc) {
            __builtin_amdgcn_fence(__ATOMIC_RELEASE, "agent");
            asm volatile("s_waitcnt vmcnt(0)" ::: "memory");
            const unsigned og = xb_add(&bar[XB_TOP], 1u);
            const unsigned tg = og / nx;
            if (og + 1u == (tg + 1u) * nx) xb_add(&bar[XB_TOPGEN], 1u);
            else XB_SPIN(xb_ld(&bar[XB_TOPGEN]) == tg, bar);
            __builtin_amdgcn_fence(__ATOMIC_ACQUIRE, "agent");
            xb_add(&bar[XB_XGEN(b.x)], 1u);
            asm volatile("s_waitcnt vmcnt(0)" ::: "memory");
        } else {
            XB_SPIN(xb_ld(&bar[XB_XGEN(b.x)]) == gen, bar);
            __builtin_amdgcn_fence(__ATOMIC_ACQUIRE, "agent");
            asm volatile("s_waitcnt vmcnt(0)" ::: "memory");
        }
    }
    __syncthreads();
}

namespace att {
typedef float f32x16 __attribute__((ext_vector_type(16)));
typedef short s16x4 __attribute__((ext_vector_type(4)));
constexpr float SB_DONE = 281474976710656.0f;
constexpr int SHM_K = 64 * 128 * 2, SHM_V = 64 * 128 * 2, SHM_P = 64 * 64 * 2;
#define KSWZ(row, colB) ((row) * 256 + ((colB) ^ (((row) & 7) << 4)))
#define PSWZ(row, colB) ((row) * 128 + ((colB) ^ ((((row) >> 1) & 7) << 4)))
#define SBAR() __builtin_amdgcn_sched_barrier(0)
__device__ __forceinline__ int v_st(int k, int c) { const int kk = (k & ~0xC) | ((k & 4) << 1) | ((k & 8) >> 1); return ((kk >> 3) * 4 + (c >> 5)) * 512 + ((kk & 7) * 32 + (c & 31)) * 2; }
__device__ __forceinline__ int v_rd_base(int lane) { return ((lane & 3) << 3) | (((lane >> 2) & 3) << 6) | (((lane >> 4) & 1) << 5) | (((lane >> 5) & 1) << 8); }
__device__ __forceinline__ unsigned cvtpk(float lo, float hi) { unsigned r; asm volatile("v_cvt_pk_bf16_f32 %0, %1, %2" : "=v"(r) : "v"(lo), "v"(hi)); return r; }
#define PK4(P, B_, OUT) do { unsigned a0 = cvtpk(P[B_+0], P[B_+1]), a1 = cvtpk(P[B_+2], P[B_+3]), b0 = cvtpk(P[B_+4], P[B_+5]), b1 = cvtpk(P[B_+6], P[B_+7]); \
        auto r0 = __builtin_amdgcn_permlane32_swap(a0, b0, false, false); auto r1 = __builtin_amdgcn_permlane32_swap(a1, b1, false, false); \
        v4u w = {r0[0], r1[0], r0[1], r1[1]}; OUT = __builtin_bit_cast(bf16x8, w); } while (0)
__device__ __forceinline__ void qkt128(f32x16& p0, f32x16& p1, const LAS unsigned char* Kt, int r32, int hi, const bf16x8* qr) {
    const LAS unsigned char* kb[4];
#pragma unroll
    for (int dd = 0; dd < 4; ++dd) kb[dd] = Kt + KSWZ(r32, (dd * 16 + hi * 8) * 2);
#pragma unroll
    for (int d0 = 0; d0 < 8; ++d0) { const LAS unsigned char* a = kb[d0 & 3] + (d0 >> 2) * 128;
        const bf16x8 b0 = *(const LAS bf16x8*)a, b1 = *(const LAS bf16x8*)(a + 32 * 256);
        p0 = __builtin_amdgcn_mfma_f32_32x32x16_bf16(b0, qr[d0], p0, 0, 0, 0);
        p1 = __builtin_amdgcn_mfma_f32_32x32x16_bf16(b1, qr[d0], p1, 0, 0, 0); }
}
__device__ __forceinline__ void pv_tile(f32x16* o, int vb, bf16x8 pa0, bf16x8 pa1, bf16x8 pa2, bf16x8 pa3) {
#define TRRD(dst, off) asm volatile("ds_read_b64_tr_b16 %0, %1 offset:%2" : "=&v"(dst) : "v"(vb), "i"(off) : "memory")
#define PV_RD(S, d0) do { constexpr int b_ = (d0) * 512; TRRD(S##l0, b_); TRRD(S##h0, b_ + 2048); TRRD(S##l1, b_ + 4096); TRRD(S##h1, b_ + 6144); TRRD(S##l2, b_ + 8192); TRRD(S##h2, b_ + 10240); TRRD(S##l3, b_ + 12288); TRRD(S##h3, b_ + 14336); } while (0)
#define PV_MM(S, d0) do { \
        o[d0] = __builtin_amdgcn_mfma_f32_32x32x16_bf16((bf16x8){S##l0[0], S##l0[1], S##l0[2], S##l0[3], S##h0[0], S##h0[1], S##h0[2], S##h0[3]}, pa0, o[d0], 0, 0, 0); \
        o[d0] = __builtin_amdgcn_mfma_f32_32x32x16_bf16((bf16x8){S##l1[0], S##l1[1], S##l1[2], S##l1[3], S##h1[0], S##h1[1], S##h1[2], S##h1[3]}, pa1, o[d0], 0, 0, 0); \
        o[d0] = __builtin_amdgcn_mfma_f32_32x32x16_bf16((bf16x8){S##l2[0], S##l2[1], S##l2[2], S##l2[3], S##h2[0], S##h2[1], S##h2[2], S##h2[3]}, pa2, o[d0], 0, 0, 0); \
        o[d0] = __builtin_amdgcn_mfma_f32_32x32x16_bf16((bf16x8){S##l3[0], S##l3[1], S##l3[2], S##l3[3], S##h3[0], S##h3[1], S##h3[2], S##h3[3]}, pa3, o[d0], 0, 0, 0); } while (0)
    s16x4 Al0, Al1, Al2, Al3, Ah0, Ah1, Ah2, Ah3, Bl0, Bl1, Bl2, Bl3, Bh0, Bh1, Bh2, Bh3;
    PV_RD(A, 0); PV_RD(B, 1);
    asm volatile("s_waitcnt lgkmcnt(8)" ::: "memory"); SBAR(); PV_MM(A, 0); SBAR();
    PV_RD(A, 2);
    asm volatile("s_waitcnt lgkmcnt(8)" ::: "memory"); SBAR(); PV_MM(B, 1); SBAR();
    PV_RD(B, 3);
    asm volatile("s_waitcnt lgkmcnt(8)" ::: "memory"); SBAR(); PV_MM(A, 2); SBAR();
    asm volatile("s_waitcnt lgkmcnt(0)" ::: "memory"); SBAR(); PV_MM(B, 3);
#undef PV_RD
#undef PV_MM
#undef TRRD
}
typedef __bf16 bf16x2_t __attribute__((ext_vector_type(2)));
__device__ __forceinline__ unsigned cvtpk_c(float a, float b) { const f32x2 f = {a, b}; return __builtin_bit_cast(unsigned, __builtin_convertvector(f, bf16x2_t)); }
__device__ __forceinline__ void store_o(const f32x16* o, bf16* Ow  , int r32, int hi, float scale) {
    bf16* row = Ow + (size_t)r32 * 2048 + hi * 8;
#pragma unroll
    for (int d0 = 0; d0 < 4; ++d0) {
#pragma unroll
        for (int b8 = 0; b8 < 16; b8 += 8) {
            const unsigned a0 = cvtpk_c(o[d0][b8 + 0] * scale, o[d0][b8 + 1] * scale), a1 = cvtpk_c(o[d0][b8 + 2] * scale, o[d0][b8 + 3] * scale);
            const unsigned b0 = cvtpk_c(o[d0][b8 + 4] * scale, o[d0][b8 + 5] * scale), b1 = cvtpk_c(o[d0][b8 + 6] * scale, o[d0][b8 + 7] * scale);
            auto r0 = __builtin_amdgcn_permlane32_swap(a0, b0, false, false); auto r1 = __builtin_amdgcn_permlane32_swap(a1, b1, false, false);
            *(v4u*)(row + d0 * 32 + 2 * b8) = (v4u){r0[0], r1[0], r0[1], r1[1]}; } }
}

__device__ __forceinline__ void sb_unit(const bf16* __restrict__ qkv, bf16* __restrict__ ob, int b, int h, int qb, LAS unsigned char* lds) {
    int tid_ = threadIdx.x; asm volatile("" : "+v"(tid_));
    const int tid = tid_, wid = __builtin_amdgcn_readfirstlane(tid >> 6), lane = tid & 63, r32 = lane & 31, hi = lane >> 5;
    const size_t rowbase = (size_t)b * SEQ; const int q0 = qb * 256;
    const bf16* Kg = qkv + rowbase * 6144 + 2048 + h * 128; const bf16* Vg = qkv + rowbase * 6144 + 4096 + h * 128;
    LAS unsigned char* V_lds = lds; LAS unsigned char* K_lds = lds + 2 * SHM_V;
    const int sr = tid >> 4, sc = (tid & 15) * 8, vst0 = v_st(sr, sc), vst1 = v_st(32 + sr, sc), kws = KSWZ(sr, sc * 2);
    const int vb0 = (int)(unsigned)(uintptr_t)V_lds + v_rd_base(lane);
    bf16x8 qr[8];
    { const bf16* Qw = qkv + (rowbase + q0 + wid * 32 + r32) * 6144 + h * 128;
#pragma unroll
      for (int d0 = 0; d0 < 8; ++d0) qr[d0] = *(const bf16x8*)(Qw + d0 * 16 + hi * 8); }
    const int NT = 4 * qb + 4;
    const int jmax = 4 * qb + (wid >> 1);
    const int qrow = q0 + wid * 32 + r32;
    f32x16 o[4]; o[0] = f32x16{}; o[1] = f32x16{}; o[2] = f32x16{}; o[3] = f32x16{};
    float run = 1.0f;
    bf16x8 st_k0, st_k1, st_v0, st_v1;
#define SLOAD(jt) do { const size_t k0_ = (size_t)(jt) * 64; st_v0 = *(const bf16x8*)(Vg + (k0_ + sr) * 6144 + sc); st_v1 = *(const bf16x8*)(Vg + (k0_ + 32 + sr) * 6144 + sc); \
                       st_k0 = *(const bf16x8*)(Kg + (k0_ + sr) * 6144 + sc); st_k1 = *(const bf16x8*)(Kg + (k0_ + 32 + sr) * 6144 + sc); } while (0)
#define SWRITE(bf) do { *(LAS bf16x8*)(V_lds + (bf) * SHM_V + vst0) = st_v0; *(LAS bf16x8*)(V_lds + (bf) * SHM_V + vst1) = st_v1; \
                        *(LAS bf16x8*)(K_lds + (bf) * SHM_K + kws) = st_k0; *(LAS bf16x8*)(K_lds + (bf) * SHM_K + kws + 32 * 256) = st_k1; } while (0)
    SLOAD(NT - 1); VM_WAIT(); SWRITE(0); if (NT > 1) SLOAD(NT - 2);
    __syncthreads();
    bool wdone = false;
    for (int i = 0; i < NT; ++i) {
        const int jt = NT - 1 - i, bf = i & 1;
        if (jt <= jmax && !wdone) {
            f32x16 p0 = f32x16{}, p1 = f32x16{}, u0, u1;
            qkt128(p0, p1, K_lds + bf * SHM_K, r32, hi, qr);
            const int dq = qrow - jt * 64 - 4 * hi;
            const bool need_mask = (jt * 64 + 63 >= q0 + wid * 32);
#define SB_EU(MASKED) do { _Pragma("unroll") for (int r = 0; r < 16; ++r) { const int c = (r & 3) + 8 * (r >> 2); \
                { float E = __builtin_amdgcn_exp2f(fminf(p0[r], 64.f)); float u = 1.0f + E; if (MASKED && !(c < dq)) { E = 0.f; u = 1.0f; } p0[r] = E; u0[r] = u; } \
                { float E = __builtin_amdgcn_exp2f(fminf(p1[r], 64.f)); float u = 1.0f + E; if (MASKED && !(c + 32 < dq)) { E = 0.f; u = 1.0f; } p1[r] = E; u1[r] = u; } } } while (0)
            if (need_mask) SB_EU(true); else SB_EU(false);
#undef SB_EU
            float Ip[9], oth[9];
#pragma unroll
            for (int j = 0; j < 4; ++j) { u0[4 * j + 2] *= u0[4 * j + 3]; u0[4 * j + 1] *= u0[4 * j + 2]; u0[4 * j] *= u0[4 * j + 1];
                                          u1[4 * j + 2] *= u1[4 * j + 3]; u1[4 * j + 1] *= u1[4 * j + 2]; u1[4 * j] *= u1[4 * j + 1]; }
            Ip[8] = 1.0f; Ip[7] = u1[12];
#pragma unroll
            for (int j = 6; j >= 0; --j) Ip[j] = Ip[j + 1] * ((j < 4) ? u0[4 * j] : u1[4 * (j - 4)]);
#pragma unroll
            for (int j = 0; j < 8; ++j) { auto rr = __builtin_amdgcn_permlane32_swap(__float_as_uint(Ip[j]), __float_as_uint(Ip[j + 1]), false, false); oth[j] = __uint_as_float(hi ? rr[0] : rr[1]); }
            { auto rr = __builtin_amdgcn_permlane32_swap(__float_as_uint(Ip[0]), __float_as_uint(Ip[0]), false, false); oth[8] = __uint_as_float(hi ? rr[0] : rr[1]); }
#pragma unroll
            for (int j = 0; j < 8; ++j) {
                const float T = (Ip[j + 1] * oth[j]) * run;
#pragma unroll
                for (int e = 0; e < 4; ++e) {
                    if (j < 4) p0[4 * j + e] *= __builtin_amdgcn_rcpf(u0[4 * j + e] * T);
                    else       p1[4 * (j - 4) + e] *= __builtin_amdgcn_rcpf(u1[4 * (j - 4) + e] * T); }
            }
            run *= Ip[0] * oth[8];
            bf16x8 pa0, pa1, pa2, pa3;
            PK4(p0, 0, pa0); PK4(p0, 8, pa1); PK4(p1, 0, pa2); PK4(p1, 8, pa3);
            SBAR();
            pv_tile(o, vb0 + bf * SHM_V, pa0, pa1, pa2, pa3);
        }
        if (i + 1 < NT) { VM_WAIT(); SWRITE((i + 1) & 1); if (i + 2 < NT) SLOAD(NT - 3 - i); }
        { LAS unsigned* fl = (LAS unsigned*)(lds + 2 * SHM_V + 2 * SHM_K) + (i & 1) * 8;
          wdone = __all(run >= SB_DONE);
          if (lane == 0) fl[wid] = wdone ? 1u : 0u;
          __syncthreads();
          const v4u f0 = *(const LAS v4u*)fl, f1 = *(const LAS v4u*)(fl + 4);
          if ((f0.x & f0.y & f0.z & f0.w & f1.x & f1.y & f1.z & f1.w) != 0u) break; }
    }
#undef SLOAD
#undef SWRITE
    store_o(o, ob + (rowbase + q0 + wid * 32) * 2048 + h * 128, r32, hi, 1.0f);
}
__device__ __forceinline__ void sb_phase(const bf16* qkv, bf16* ob, LAS unsigned char* lds, int vcu, int G) {
    for (int item = vcu; item < BATCH * NH * 16; item += G) {
        const int bh = item >> 4, x = item & 15;
        sb_unit(qkv, ob, bh / NH, bh % NH, 31 - x, lds);
        sb_unit(qkv, ob, bh / NH, bh % NH, x, lds);
    }
}

__device__ __forceinline__ void mla_unit(const bf16* __restrict__ qm, const bf16* __restrict__ kvm, const bf16* __restrict__ kpe, bf16* __restrict__ ob, int b, int h, int qb, LAS unsigned char* lds) {
    int tid_ = threadIdx.x; asm volatile("" : "+v"(tid_));
    const int tid = tid_, wid = __builtin_amdgcn_readfirstlane(tid >> 6), lane = tid & 63, r32 = lane & 31, hi = lane >> 5;
    const size_t rowbase = (size_t)b * SEQ; const int q0 = qb * 256;
    const bf16* Kg = kvm + rowbase * 4096 + h * 256; const bf16* Vg = Kg + 128; const bf16* Pg = kpe + rowbase * 64;
    LAS unsigned char* V_lds = lds; LAS unsigned char* K_lds = lds + 2 * SHM_V; LAS unsigned char* P_lds = lds + 2 * SHM_V + 2 * SHM_K;
    (void)0;
    const int sr = tid >> 4, sc = (tid & 15) * 8, vst0 = v_st(sr, sc), vst1 = v_st(32 + sr, sc), kws = KSWZ(sr, sc * 2);
    const int pr = tid >> 3, pc = (tid & 7) * 8, pws = PSWZ(pr, pc * 2);
    const int vb0 = (int)(unsigned)(uintptr_t)V_lds + v_rd_base(lane);
    bf16x8 qr[12];
    { const bf16* Qw = qm + (rowbase + q0 + wid * 32 + r32) * 3072 + h * 192;
#pragma unroll
      for (int d0 = 0; d0 < 12; ++d0) qr[d0] = *(const bf16x8*)(Qw + d0 * 16 + hi * 8); }
    const int NT = 4 * qb + 4, jmax = 4 * qb + (wid >> 1);
    f32x16 o[4]; o[0] = f32x16{}; o[1] = f32x16{}; o[2] = f32x16{}; o[3] = f32x16{};
    float m_reg = -1e30f, l_reg = 0.f;
    bf16x8 sa_k0, sa_k1, sa_v0, sa_v1, sa_p, sb_k0, sb_k1, sb_v0, sb_v1, sb_p;
#define SLOAD(S, jt) do { const size_t k0_ = (size_t)(jt) * 64; S##_v0 = *(const bf16x8*)(Vg + (k0_ + sr) * 4096 + sc); S##_v1 = *(const bf16x8*)(Vg + (k0_ + 32 + sr) * 4096 + sc); \
                          S##_k0 = *(const bf16x8*)(Kg + (k0_ + sr) * 4096 + sc); S##_k1 = *(const bf16x8*)(Kg + (k0_ + 32 + sr) * 4096 + sc); S##_p = *(const bf16x8*)(Pg + (k0_ + pr) * 64 + pc); } while (0)
#define SWRITE(S, bf) do { *(LAS bf16x8*)(V_lds + (bf) * SHM_V + vst0) = S##_v0; *(LAS bf16x8*)(V_lds + (bf) * SHM_V + vst1) = S##_v1; \
                           *(LAS bf16x8*)(K_lds + (bf) * SHM_K + kws) = S##_k0; *(LAS bf16x8*)(K_lds + (bf) * SHM_K + kws + 32 * 256) = S##_k1; *(LAS bf16x8*)(P_lds + (bf) * SHM_P + pws) = S##_p; } while (0)
    SLOAD(sa, 0); SLOAD(sb, 1); SWRITE(sa, 0); SLOAD(sa, 2);
    __syncthreads();
    auto tile = [&](const int jt, const int bf) __attribute__((always_inline)) {
        if (jt <= jmax) {
            f32x16 p0 = f32x16{}, p1 = f32x16{};
            qkt128(p0, p1, K_lds + bf * SHM_K, r32, hi, qr);
            { const LAS unsigned char* Pt = P_lds + bf * SHM_P;
#pragma unroll
              for (int dd = 0; dd < 4; ++dd) { const LAS unsigned char* a = Pt + PSWZ(r32, (dd * 16 + hi * 8) * 2);
                  const bf16x8 b0 = *(const LAS bf16x8*)a, b1 = *(const LAS bf16x8*)(a + 32 * 128);
                  p0 = __builtin_amdgcn_mfma_f32_32x32x16_bf16(b0, qr[8 + dd], p0, 0, 0, 0);
                  p1 = __builtin_amdgcn_mfma_f32_32x32x16_bf16(b1, qr[8 + dd], p1, 0, 0, 0); } }
            float pmax = p0[0];
#pragma unroll
            for (int r = 1; r < 16; ++r) pmax = fmaxf(pmax, p0[r]);
#pragma unroll
            for (int r = 0; r < 16; ++r) pmax = fmaxf(pmax, p1[r]);
            { auto rr = __builtin_amdgcn_permlane32_swap(__float_as_uint(pmax), __float_as_uint(pmax), false, false); pmax = fmaxf(__uint_as_float(rr[0]), __uint_as_float(rr[1])); }
            const float mn = fmaxf(m_reg, pmax); const float alpha = __builtin_amdgcn_exp2f(m_reg - mn); m_reg = mn;
            float ps = 0.f;
#pragma unroll
            for (int r = 0; r < 16; ++r) { p0[r] = __builtin_amdgcn_exp2f(p0[r] - mn); p1[r] = __builtin_amdgcn_exp2f(p1[r] - mn); ps += p0[r] + p1[r]; }
            { auto rr = __builtin_amdgcn_permlane32_swap(__float_as_uint(ps), __float_as_uint(ps), false, false); ps = __uint_as_float(rr[0]) + __uint_as_float(rr[1]); }
            l_reg = l_reg * alpha + ps;
            if (__any(alpha < 1.f)) {
#pragma unroll
                for (int d0 = 0; d0 < 4; ++d0) o[d0] = o[d0] * alpha;
            }
            bf16x8 pa0, pa1, pa2, pa3;
            PK4(p0, 0, pa0); PK4(p0, 8, pa1); PK4(p1, 0, pa2); PK4(p1, 8, pa3);
            SBAR();
            pv_tile(o, vb0 + bf * SHM_V, pa0, pa1, pa2, pa3);
        }
    };
    for (int jt = 0; jt < NT; jt += 2) {
        tile(jt, 0);
        SWRITE(sb, 1); if (jt + 3 < NT) SLOAD(sb, jt + 3);
        __syncthreads();
        tile(jt + 1, 1);
        if (jt + 2 < NT) { SWRITE(sa, 0); if (jt + 4 < NT) SLOAD(sa, jt + 4); }
        __syncthreads();
    }
#undef SLOAD
#undef SWRITE
    store_o(o, ob + (rowbase + q0 + wid * 32) * 2048 + h * 128, r32, hi, 1.0f / l_reg);
}
__device__ __forceinline__ void mla_phase(const bf16* qm, const bf16* kvm, const bf16* kpe, bf16* ob, LAS unsigned char* lds, int vcu, int G) {
    for (int item = vcu; item < BATCH * NH * 16; item += G) {
        const int bh = item >> 4, x = item & 15;
        mla_unit(qm, kvm, kpe, ob, bh / NH, bh % NH, 31 - x, lds);
        mla_unit(qm, kvm, kpe, ob, bh / NH, bh % NH, x, lds);
    }
}
#undef KSWZ
#undef PSWZ
#undef SBAR
#undef PK4
}

namespace hg {
using att::f32x16; using att::s16x4;
#define KSWZ(row, colB) ((row) * 256 + ((colB) ^ (((row) & 7) << 4)))
#define TRRD(dst, base, off) asm volatile("ds_read_b64_tr_b16 %0, %1 offset:%2" : "=&v"(dst) : "v"(base), "i"(off) : "memory")
#define FRAG(dst, base, ks) do { s16x4 lo_, hi_; TRRD(lo_, base, (ks) * 4096); TRRD(hi_, base, (ks) * 4096 + 2048); asm volatile("s_waitcnt lgkmcnt(0)" ::: "memory"); __builtin_amdgcn_sched_barrier(0);   \
        dst = (bf16x8){lo_[0], lo_[1], lo_[2], lo_[3], hi_[0], hi_[1], hi_[2], hi_[3]}; } while (0)
typedef __bf16 bf16x2_t __attribute__((ext_vector_type(2)));
__device__ __forceinline__ unsigned cvtpk_c(float a, float b) { const f32x2 f = {a, b}; return __builtin_bit_cast(unsigned, __builtin_convertvector(f, bf16x2_t)); }
__device__ __forceinline__ int crow(int r, int hi) { return (r & 3) + 8 * (r >> 2) + 4 * hi; }
__device__ __forceinline__ void st_bf16(LAS unsigned char* p, float v) { *(LAS unsigned short*)p = (unsigned short)f2bf(v); }

__device__ __forceinline__ void pass_a(const bf16* __restrict__ ib, const float* __restrict__ lf, bf16* __restrict__ kvs, float* __restrict__ dec, LAS unsigned char* lds, int vcu, int G) {
    int tid_ = threadIdx.x; asm volatile("" : "+v"(tid_));
    const int tid = tid_, wid = __builtin_amdgcn_readfirstlane(tid >> 6), lane = tid & 63, r32 = lane & 31, hi = lane >> 5;
    LAS unsigned char* Kh = lds; LAS unsigned char* Vt = lds + 16384; LAS float* tot = (LAS float*)(lds + 32768);
    const int sr = tid >> 4, sc = (tid & 15) * 8;
    const int c4 = (tid & 31) * 4, rg = tid >> 5, rg0 = 2 * wid;
    const int vblk = wid >> 1, cblk0 = 2 * (wid & 1);
    const int vbV = (int)(unsigned)(uintptr_t)Vt + att::v_rd_base(lane) + vblk * 512, vbK = (int)(unsigned)(uintptr_t)Kh + att::v_rd_base(lane) + cblk0 * 512;
    bf16x8 st_v0, st_v1; f32x4 lw[4];
#define A_LOAD(U) do { const int bh_ = (U) >> 7, n_ = (U) & 127; const size_t r0_ = (size_t)(bh_ >> 4) * SEQ + (size_t)n_ * 64; const int h_ = bh_ & 15; \
        st_v0 = *(const bf16x8*)(ib + (r0_ + sr) * 2048 + h_ * 128 + sc); st_v1 = *(const bf16x8*)(ib + (r0_ + 32 + sr) * 2048 + h_ * 128 + sc); \
        _Pragma("unroll") for (int j = 0; j < 4; ++j) lw[j] = *(const f32x4*)(lf + (r0_ + 4 * rg + j) * 2048 + h_ * 128 + c4); } while (0)
    if (vcu < BATCH * NH * NCHUNK) A_LOAD(vcu);
    for (int unit = vcu; unit < BATCH * NH * NCHUNK; unit += G) {
        f32x4 bb[4];
        bb[0] = lw[0]; bb[1] = bb[0] + lw[1]; bb[2] = bb[1] + lw[2]; bb[3] = bb[2] + lw[3];
        *(LAS f32x4*)(tot + rg * 128 + c4) = bb[3];
        *(LAS bf16x8*)(Vt + att::v_st(sr, sc)) = st_v0; *(LAS bf16x8*)(Vt + att::v_st(32 + sr, sc)) = st_v1;
        __syncthreads();
        f32x4 offs = (f32x4){0.f, 0.f, 0.f, 0.f};
        for (int g = 0; g < rg0; ++g) offs = offs + *(const LAS f32x4*)(tot + g * 128 + c4);
        f32x4 blast = offs;
        { const f32x4 own0 = *(const LAS f32x4*)(tot + rg0 * 128 + c4); blast = blast + own0; if (rg != rg0) offs = offs + own0; }
        for (int g = rg0 + 1; g < 16; ++g) blast = blast + *(const LAS f32x4*)(tot + g * 128 + c4);
#pragma unroll
        for (int j = 0; j < 4; ++j) { const f32x4 bf = bb[j] + offs; float kh[4];
#pragma unroll
            for (int e = 0; e < 4; ++e) kh[e] = (1.0f - __expf(lw[j][e])) * __expf(blast[e] - bf[e]);
            v2u w; w.x = pk2(kh[0], kh[1]); w.y = pk2(kh[2], kh[3]);
            *(LAS v2u*)(Kh + att::v_st(4 * rg + j, c4)) = w; }
        if (unit + G < BATCH * NH * NCHUNK) A_LOAD(unit + G);
        if (rg == 0) { f32x4 d4; d4[0] = __expf(blast[0]); d4[1] = __expf(blast[1]); d4[2] = __expf(blast[2]); d4[3] = __expf(blast[3]); *(f32x4*)(dec + (size_t)unit * 128 + c4) = d4; }
        __syncthreads();
        f32x16 a0 = f32x16{}, a1 = f32x16{};
#pragma unroll
        for (int ks = 0; ks < 4; ++ks) { bf16x8 fa, fb0, fb1; FRAG(fa, vbV, ks); FRAG(fb0, vbK, ks); { const int vbK1 = vbK + 512; FRAG(fb1, vbK1, ks); }
            a0 = __builtin_amdgcn_mfma_f32_32x32x16_bf16(fb0, fa, a0, 0, 0, 0); a1 = __builtin_amdgcn_mfma_f32_32x32x16_bf16(fb1, fa, a1, 0, 0, 0); }
        bf16* dst = kvs + (size_t)unit * 16384 + (size_t)(vblk * 32 + r32) * 128 + cblk0 * 32 + hi * 8;
#define A_PK4(P, B_, OUT) do { unsigned a0_ = cvtpk_c(P[B_+0], P[B_+1]), a1_ = cvtpk_c(P[B_+2], P[B_+3]), b0_ = cvtpk_c(P[B_+4], P[B_+5]), b1_ = cvtpk_c(P[B_+6], P[B_+7]); \
        auto r0_ = __builtin_amdgcn_permlane32_swap(a0_, b0_, false, false); auto r1_ = __builtin_amdgcn_permlane32_swap(a1_, b1_, false, false); \
        OUT = (v4u){r0_[0], r1_[0], r0_[1], r1_[1]}; } while (0)
        { v4u w0, w1, w2, w3; A_PK4(a0, 0, w0); A_PK4(a0, 8, w1); A_PK4(a1, 0, w2); A_PK4(a1, 8, w3);
          *(v4u*)(dst) = w0; *(v4u*)(dst + 16) = w1; *(v4u*)(dst + 32) = w2; *(v4u*)(dst + 48) = w3; }
#undef A_PK4
        __syncthreads();
    }
#undef A_LOAD
}
__device__ __forceinline__ void pass_b(bf16* __restrict__ kvs, const float* __restrict__ dec, LAS unsigned char* lds, int vcu, int G) {
    int tid_ = threadIdx.x; asm volatile("" : "+v"(tid_));
    LAS float* dl = (LAS float*)lds;
    for (int idx = vcu * 512 + tid_; idx < BATCH * NH * 8192; idx += G * 512) {
        const int bh = idx >> 13, rem = idx & 8191, v = rem >> 6, cp = rem & 63;
        unsigned* p = (unsigned*)(kvs + (size_t)bh * 128 * 16384 + v * 128 + 2 * cp);
        __syncthreads();
        { const float* dsrc = dec + (size_t)bh * 128 * 128;
#pragma unroll
          for (int j = 0; j < 8; ++j) *(LAS f32x4*)(dl + (tid_ + 512 * j) * 4) = *(const f32x4*)(dsrc + (tid_ + 512 * j) * 4); }
        __syncthreads();
        const LAS float* dq = dl + 2 * cp;
        float S0 = 0.f, S1 = 0.f;
        unsigned la[32], lb[32];
#define B_LOAD(L, N0) do { _Pragma("unroll") for (int k = 0; k < 32; ++k) L[k] = p[(size_t)((N0) + k) * 8192]; } while (0)
#define B_STEP(L, N0) do { _Pragma("unroll") for (int k = 0; k < 32; ++k) { const f32x2 dd = *(const LAS f32x2*)(dq + ((N0) + k) * 128); p[(size_t)((N0) + k) * 8192] = pk2(S0, S1); \
                S0 = dd.x * S0 + __builtin_bit_cast(float, L[k] << 16); S1 = dd.y * S1 + __builtin_bit_cast(float, L[k] & 0xffff0000u); } } while (0)
        B_LOAD(la, 0);
        for (int n0 = 0; n0 < NCHUNK; n0 += 64) {
            B_LOAD(lb, n0 + 32);
            B_STEP(la, n0);
            if (n0 + 64 < NCHUNK) B_LOAD(la, n0 + 64);
            B_STEP(lb, n0 + 32);
        }
#undef B_LOAD
#undef B_STEP
    }
}
__device__ __forceinline__ void pass_c(const bf16* __restrict__ qb, const bf16* __restrict__ ib, const bf16* __restrict__ gb, const float* __restrict__ lf, const bf16* __restrict__ kvs,
                                       const float* __restrict__ gnorm, bf16* __restrict__ ob, LAS unsigned char* lds, int vcu, int G) {
    int tid_ = threadIdx.x; asm volatile("" : "+v"(tid_));
    const int tid = tid_, wid = __builtin_amdgcn_readfirstlane(tid >> 6), lane = tid & 63, r32 = lane & 31, hi = lane >> 5;
    LAS unsigned char* Kt = lds; LAS unsigned char* Vt = lds + 16384; LAS unsigned char* Qt = lds + 32768; LAS unsigned char* Qi = lds + 49152;
    LAS float* tot = (LAS float*)(lds + 65536); LAS float* sst = (LAS float*)(lds + 73728);
    const int sr = tid >> 4, sc = (tid & 15) * 8;
    const int c4 = (tid & 31) * 4, rg = tid >> 5, rg0 = 2 * wid;
    const int tb = wid & 1, vblk = wid >> 1;
    const int vbV = (int)(unsigned)(uintptr_t)Vt + att::v_rd_base(lane) + vblk * 512;
    bf16x8 st_v0, st_v1; v2u g0[4], ng0[4]; f32x4 lw[4]; v2u qw[4];
    f32x4 gn[4];
#pragma unroll
    for (int g = 0; g < 4; ++g) gn[g] = *(const f32x4*)(gnorm + 32 * vblk + 8 * g + 4 * hi);
#define C_LOAD(U, G0) do { const int bh_ = (U) >> 7, n_ = (U) & 127; const size_t r0_ = (size_t)(bh_ >> 4) * SEQ + (size_t)n_ * 64; const int h_ = bh_ & 15; \
        st_v0 = *(const bf16x8*)(ib + (r0_ + sr) * 2048 + h_ * 128 + sc); st_v1 = *(const bf16x8*)(ib + (r0_ + 32 + sr) * 2048 + h_ * 128 + sc); \
        _Pragma("unroll") for (int j = 0; j < 4; ++j) { const size_t e_ = (r0_ + 4 * rg + j) * 2048 + h_ * 128 + c4; lw[j] = *(const f32x4*)(lf + e_); qw[j] = *(const v2u*)(qb + e_); } \
        { const size_t e_ = (r0_ + tb * 32 + r32) * 2048 + h_ * 128 + 32 * vblk + 4 * hi; _Pragma("unroll") for (int g = 0; g < 4; ++g) G0[g] = *(const v2u*)(gb + e_ + 8 * g); } } while (0)
    if (vcu < BATCH * NH * NCHUNK) C_LOAD(vcu, g0);
    for (int unit = vcu; unit < BATCH * NH * NCHUNK; unit += G) {
        const int bh = unit >> 7, n = unit & 127, b = bh >> 4, h = bh & 15; const size_t r0 = (size_t)b * SEQ + (size_t)n * 64;
        bf16x8 sf[8];
        { const bf16* Sg = kvs + (size_t)unit * 16384 + (size_t)(vblk * 32 + r32) * 128 + hi * 8;
#pragma unroll
          for (int d0 = 0; d0 < 8; ++d0) sf[d0] = *(const bf16x8*)(Sg + d0 * 16); }
        f32x4 bb[4];
        bb[0] = lw[0]; bb[1] = bb[0] + lw[1]; bb[2] = bb[1] + lw[2]; bb[3] = bb[2] + lw[3];
        *(LAS f32x4*)(tot + rg * 128 + c4) = bb[3];
        *(LAS bf16x8*)(Vt + att::v_st(sr, sc)) = st_v0; *(LAS bf16x8*)(Vt + att::v_st(32 + sr, sc)) = st_v1;
        __syncthreads();
        f32x4 offs, bm;
        { f32x4 S = (f32x4){0.f, 0.f, 0.f, 0.f}; const int gm = rg0 < 8 ? rg0 : 8;
          for (int g = 0; g < gm; ++g) S = S + *(const LAS f32x4*)(tot + g * 128 + c4);
          if (rg0 <= 8) { offs = S; f32x4 T = S; for (int g = rg0; g < 8; ++g) T = T + *(const LAS f32x4*)(tot + g * 128 + c4); bm = T; }
          else { bm = S; for (int g = 8; g < rg0; ++g) S = S + *(const LAS f32x4*)(tot + g * 128 + c4); offs = S; }
          if (rg != rg0) offs = offs + *(const LAS f32x4*)(tot + rg0 * 128 + c4); }
#pragma unroll
        for (int j = 0; j < 4; ++j) { const int row = 4 * rg + j; const f32x4 bf = bb[j] + offs; float kt[4], qt[4], qi[4];
            const float q4[4] = {__builtin_bit_cast(float, qw[j].x << 16), __builtin_bit_cast(float, qw[j].x & 0xffff0000u), __builtin_bit_cast(float, qw[j].y << 16), __builtin_bit_cast(float, qw[j].y & 0xffff0000u)};
#pragma unroll
            for (int e = 0; e < 4; ++e) { const float dm = bf[e] - bm[e];
                qi[e] = q4[e] * __expf(bf[e]); qt[e] = q4[e] * __expf(fminf(dm, 80.f)); kt[e] = (1.0f - __expf(lw[j][e])) * __expf(fminf(-dm, 80.f)); }
            const int off = KSWZ(row, c4 * 2);
            { v2u w; w.x = pk2(kt[0], kt[1]); w.y = pk2(kt[2], kt[3]); *(LAS v2u*)(Kt + off) = w; }
            { v2u w; w.x = pk2(qt[0], qt[1]); w.y = pk2(qt[2], qt[3]); *(LAS v2u*)(Qt + off) = w; }
            { v2u w; w.x = pk2(qi[0], qi[1]); w.y = pk2(qi[2], qi[3]); *(LAS v2u*)(Qi + off) = w; } }
        if (unit + G < BATCH * NH * NCHUNK) C_LOAD(unit + G, ng0);
        __syncthreads();
        bf16x8 qr[8];
#pragma unroll
        for (int d0 = 0; d0 < 8; ++d0) qr[d0] = *(const LAS bf16x8*)(Qt + KSWZ(tb * 32 + r32, (d0 * 16 + hi * 8) * 2));
        f32x16 p0 = f32x16{}, p1 = f32x16{};
        att::qkt128(p0, p1, Kt, r32, hi, qr);
        const int t = tb * 32 + r32;
#pragma unroll
        for (int r = 0; r < 16; ++r) { const int s = crow(r, hi); if (!(s <= t)) p0[r] = 0.f; if (!(s + 32 <= t)) p1[r] = 0.f; }
        bf16x8 pa0, pa1, pa2, pa3;
#define PK4(P, B_, OUT) do { unsigned a0_ = att::cvtpk(P[B_+0], P[B_+1]), a1_ = att::cvtpk(P[B_+2], P[B_+3]), b0_ = att::cvtpk(P[B_+4], P[B_+5]), b1_ = att::cvtpk(P[B_+6], P[B_+7]); \
        auto r0_ = __builtin_amdgcn_permlane32_swap(a0_, b0_, false, false); auto r1_ = __builtin_amdgcn_permlane32_swap(a1_, b1_, false, false); \
        v4u w_ = {r0_[0], r1_[0], r0_[1], r1_[1]}; OUT = __builtin_bit_cast(bf16x8, w_); } while (0)
        PK4(p0, 0, pa0); PK4(p0, 8, pa1); PK4(p1, 0, pa2); PK4(p1, 8, pa3);
#undef PK4
        f32x16 o = f32x16{};
        { bf16x8 fv; FRAG(fv, vbV, 0); o = __builtin_amdgcn_mfma_f32_32x32x16_bf16(fv, pa0, o, 0, 0, 0); FRAG(fv, vbV, 1); o = __builtin_amdgcn_mfma_f32_32x32x16_bf16(fv, pa1, o, 0, 0, 0);
          FRAG(fv, vbV, 2); o = __builtin_amdgcn_mfma_f32_32x32x16_bf16(fv, pa2, o, 0, 0, 0); FRAG(fv, vbV, 3); o = __builtin_amdgcn_mfma_f32_32x32x16_bf16(fv, pa3, o, 0, 0, 0); }
#pragma unroll
        for (int d0 = 0; d0 < 8; ++d0) { const bf16x8 qf = *(const LAS bf16x8*)(Qi + KSWZ(tb * 32 + r32, (d0 * 16 + hi * 8) * 2));
            o = __builtin_amdgcn_mfma_f32_32x32x16_bf16(sf[d0], qf, o, 0, 0, 0); }
        { float ss = 0.f;
#pragma unroll
          for (int r = 0; r < 16; ++r) ss += o[r] * o[r];
          { const unsigned u = __builtin_bit_cast(unsigned, ss); auto sw = __builtin_amdgcn_permlane32_swap(u, u, false, false); ss = __builtin_bit_cast(float, (unsigned)sw[0]) + __builtin_bit_cast(float, (unsigned)sw[1]); }
          if (hi == 0) sst[(tb * 32 + r32) * 4 + vblk] = ss;
          __syncthreads();
          const f32x4 s4 = *(const LAS f32x4*)(sst + (tb * 32 + r32) * 4);
          const float rs = __builtin_amdgcn_rsqf(((s4[0] + s4[1]) + (s4[2] + s4[3])) * (1.0f / 128.0f) + RMS_EPS);
          float y[16];
#pragma unroll
          for (int g = 0; g < 4; ++g) {
              const float gg4[4] = {__builtin_bit_cast(float, g0[g].x << 16), __builtin_bit_cast(float, g0[g].x & 0xffff0000u), __builtin_bit_cast(float, g0[g].y << 16), __builtin_bit_cast(float, g0[g].y & 0xffff0000u)};
#pragma unroll
              for (int e = 0; e < 4; ++e) { const float gg = gg4[e]; y[4 * g + e] = o[4 * g + e] * rs * gn[g][e] * (gg * __builtin_amdgcn_rcpf(1.0f + __expf(-gg))); } }
          bf16* orow = ob + (r0 + tb * 32 + r32) * 2048 + h * 128 + 32 * vblk + hi * 8;
#pragma unroll
          for (int b8 = 0; b8 < 16; b8 += 8) {
              const unsigned a0_ = cvtpk_c(y[b8 + 0], y[b8 + 1]), a1_ = cvtpk_c(y[b8 + 2], y[b8 + 3]), b0_ = cvtpk_c(y[b8 + 4], y[b8 + 5]), b1_ = cvtpk_c(y[b8 + 6], y[b8 + 7]);
              auto r0_ = __builtin_amdgcn_permlane32_swap(a0_, b0_, false, false); auto r1_ = __builtin_amdgcn_permlane32_swap(a1_, b1_, false, false);
              *(v4u*)(orow + 2 * b8) = (v4u){r0_[0], r1_[0], r0_[1], r1_[1]}; } }
#pragma unroll
        for (int g = 0; g < 4; ++g) g0[g] = ng0[g];
    }
#undef C_LOAD
}
#undef KSWZ
#undef TRRD
#undef FRAG
}

struct Args { const float* in[19]; float* out; unsigned char* ws; int ph_lo, ph_hi, li, skip_mix; };

struct WDesc { const float* src; const float* gain; bf16* dst; int K, Nsrc, Nout, cmap; };
constexpr int NWMAT = 18;
__device__ __forceinline__ WDesc get_wdesc(int idx, const Args& a) {
    WDesc d; d.gain = nullptr; d.cmap = 0; unsigned char* ws = a.ws;
    if (idx < 2)       { d.src = a.in[5] + (size_t)idx * 2048 * 6144; d.K = 2048; d.Nsrc = d.Nout = 6144; d.gain = a.in[2] + (idx == 0 ? 0 : 3) * 2048; d.dst = (bf16*)(ws + W_SBQKV) + (size_t)idx * 6144 * 2048; }
    else if (idx < 4)  { const int j = idx - 2; d.src = a.in[6] + (size_t)j * 2048 * 2048; d.K = 2048; d.Nsrc = d.Nout = 2048; d.dst = (bf16*)(ws + W_SBWO) + (size_t)j * 2048 * 2048; }
    else if (idx == 4) { d.src = a.in[7]; d.K = 2048; d.Nsrc = d.Nout = 8192; d.gain = a.in[2] + 1 * 2048; d.dst = (bf16*)(ws + W_HGIN); }
    else if (idx == 5) { d.src = a.in[10]; d.K = 2048; d.Nsrc = d.Nout = 2048; d.dst = (bf16*)(ws + W_HGWO); }
    else if (idx == 6) { d.src = a.in[11]; d.K = 2048; d.Nsrc = 1344; d.Nout = 2048; d.gain = a.in[2] + 2 * 2048; d.cmap = 1; d.dst = (bf16*)(ws + W_DKV); }
    else if (idx == 7) { d.src = a.in[14]; d.K = 768; d.Nsrc = d.Nout = 3072; d.gain = a.in[12]; d.cmap = 2; d.dst = (bf16*)(ws + W_UQ); }
    else if (idx == 8) { d.src = a.in[15]; d.K = 512; d.Nsrc = d.Nout = 4096; d.gain = a.in[13]; d.dst = (bf16*)(ws + W_UKV); }
    else if (idx == 9) { d.src = a.in[16]; d.K = 2048; d.Nsrc = d.Nout = 2048; d.dst = (bf16*)(ws + W_MLAWO); }
    else if (idx < 14) { const int L = idx - 10; d.src = a.in[17] + (size_t)L * 2048 * 8192; d.K = 2048; d.Nsrc = d.Nout = 8192; d.gain = a.in[3] + L * 2048; d.dst = (bf16*)(ws + W_W1) + (size_t)L * 8192 * 2048; }
    else               { const int L = idx - 14; d.src = a.in[18] + (size_t)L * 8192 * 2048; d.K = 8192; d.Nsrc = d.Nout = 2048; d.dst = (bf16*)(ws + W_W2) + (size_t)L * 2048 * 8192; }
    return d;
}
__device__ __forceinline__ int wmap_col(int cmap, int n) {
    if (cmap == 1) { if (n < 1280) return n; if (n < 1344) { const int j = n - 1280; return 1280 + (j & 1) * 32 + (j >> 1); } return -1; }
    if (cmap == 2) { const int h = n / 192, c = n % 192; if (c < 128) return n; const int j = c - 128; return h * 192 + 128 + (j & 1) * 32 + (j >> 1); }
    return n;
}
__device__ __forceinline__ void p0_item_load(const WDesc& d, int item, int lane, float (&wv)[32]) {
    const int nblk = d.Nout / 32, kb = item / nblk, nb = item % nblk, k0 = 64 * kb, n0 = 32 * nb;
    const int src = wmap_col(d.cmap, n0 + (lane & 31));
    const float* sp = d.src + (size_t)(k0 + (lane >> 5)) * d.Nsrc + (src >= 0 ? src : 0);
#pragma unroll
    for (int i = 0; i < 32; ++i) wv[i] = __builtin_nontemporal_load(sp + (size_t)(2 * i) * d.Nsrc);
}
__device__ __forceinline__ void p0_item_store(const WDesc& d, LAS float* scr, int item, int lane, const float (&wv)[32]) {
    const int nblk = d.Nout / 32, kb = item / nblk, nb = item % nblk, k0 = 64 * kb, n0 = 32 * nb;
    const int src = wmap_col(d.cmap, n0 + (lane & 31));
#pragma unroll
    for (int i = 0; i < 32; ++i) { const int kk = 2 * i + (lane >> 5); scr[kk * 33 + (lane & 31)] = (src >= 0) ? wv[i] : 0.f; }
    LDS_WAIT(); asm volatile("" ::: "memory");
    const int c = lane & 7;
    f32x4 g0 = (f32x4){1.f, 1.f, 1.f, 1.f}, g1 = g0;
    if (d.gain) { g0 = *(const f32x4*)(d.gain + k0 + 8 * c); g1 = *(const f32x4*)(d.gain + k0 + 8 * c + 4); }
#pragma unroll
    for (int j = 0; j < 4; ++j) { const int n = (lane >> 3) + 8 * j; const LAS float* s = scr + (8 * c) * 33 + n;
        v4u o; o.x = pk2(s[0 * 33] * g0[0], s[1 * 33] * g0[1]); o.y = pk2(s[2 * 33] * g0[2], s[3 * 33] * g0[3]); o.z = pk2(s[4 * 33] * g1[0], s[5 * 33] * g1[1]); o.w = pk2(s[6 * 33] * g1[2], s[7 * 33] * g1[3]);
        *(GAS v4u*)(d.dst + (size_t)(n0 + n) * d.K + k0 + 8 * c) = o; }
    LDS_WAIT(); asm volatile("" ::: "memory");
}
__device__ __forceinline__ void p0_prologue(const Args& a, LAS unsigned char* lds, int vcu, int NGW) {
    int tid_ = threadIdx.x; asm volatile("" : "+v"(tid_)); const int lane = tid_ & 63, wave = __builtin_amdgcn_readfirstlane(tid_ >> 6), gw = vcu * NWAVES + wave;
    LAS float* scr = (LAS float*)(lds + RING_OFF + wave * 16384);
    int off = 0;
#define CONVERT_W(w) { const WDesc d = get_wdesc(w, a); const int cnt = (d.K / 64) * (d.Nout / 32); int it = ((gw - off) % NGW + NGW) % NGW; float wa[32], wb[32]; \
        if (it < cnt) p0_item_load(d, it, lane, wa); \
        for (; it < cnt; it += 2 * NGW) { if (it + NGW < cnt) p0_item_load(d, it + NGW, lane, wb); p0_item_store(d, scr, it, lane, wa); \
            if (it + NGW < cnt) { if (it + 2 * NGW < cnt) p0_item_load(d, it + 2 * NGW, lane, wa); p0_item_store(d, scr, it + NGW, lane, wb); } } off += cnt; }
    CONVERT_W(0) CONVERT_W(1) CONVERT_W(2) CONVERT_W(3) CONVERT_W(4) CONVERT_W(5) CONVERT_W(6) CONVERT_W(7) CONVERT_W(8) CONVERT_W(9)
    CONVERT_W(10) CONVERT_W(11) CONVERT_W(12) CONVERT_W(13) CONVERT_W(14) CONVERT_W(15) CONVERT_W(16) CONVERT_W(17)
#undef CONVERT_W
    pg8::u64* rowss = (pg8::u64*)(a.ws + WS_CTL + CTL_ROWSS); bf16* ab = (bf16*)(a.ws + WS_AB);
    for (int m = gw; m < M; m += NGW) {
        const GAS f32x4* xr = (const GAS f32x4*)(a.in[0] + (size_t)m * DM) + lane; GAS v2u* o8 = (GAS v2u*)(ab + (size_t)m * DM) + lane;
        f32x4 v[8]; float s = 0.f;
#pragma unroll
        for (int j = 0; j < 8; ++j) { v[j] = __builtin_nontemporal_load(xr + 64 * j); s += pg8::dot4(v[j]); }
        s = wave_sum(s);
#pragma unroll
        for (int j = 0; j < 8; ++j) { v2u w; w.x = pk2(v[j][0], v[j][1]); w.y = pk2(v[j][2], v[j][3]); o8[64 * j] = w; }
        if (lane == 0) rowss[m] = (pg8::u64)(long long)((double)s * pg8::RSS_FIX);
    }
    { const int* pos = (const int*)a.in[1]; float* cs = (float*)(a.ws + WS_CS);
      for (int e = gw * 64 + lane; e < M * 32; e += NGW * 64) { const int row = e >> 5, i = e & 31;
          const float inv_freq = exp2f(-(float)(2 * i) * (13.287712379549449f / 64.0f));
          const float ang = (float)pos[row] * inv_freq;
          double t = (double)ang * 0.15915494309189535; t -= floor(t);
          const float fr = (float)t;
          f32x2 o; o.x = __builtin_amdgcn_cosf(fr); o.y = __builtin_amdgcn_sinf(fr);
          *(f32x2*)(cs + (size_t)e * 2) = o; } }
    { const float* lg = a.in[8]; float* tab = (float*)(a.ws + WS_TAB);
      for (int c = gw * 64 + lane; c < 2048; c += NGW * 64) {
          const float l0 = lg[c], l1 = lg[2048 + c], l2 = lg[4096 + c], l3 = lg[6144 + c];
          const float mx = fmaxf(fmaxf(l0, l1), fmaxf(l2, l3));
          const float e0 = expf(l0 - mx), e1 = expf(l1 - mx), e2 = expf(l2 - mx), e3 = expf(l3 - mx); const float sum = (e0 + e1) + (e2 + e3);
          const float p0 = e0 / sum, p1 = e1 / sum; const float lb = (p0 + p1) - p0;
          tab[c] = logf(lb); tab[2048 + c] = log1pf(-lb); tab[4096 + c] = lb; tab[6144 + c] = 1.0f - lb; } }
}
__device__ __forceinline__ void final_norm_phase(const Args& a, int vcu, int NGW) {
    int tid_ = threadIdx.x; asm volatile("" : "+v"(tid_)); const int lane = tid_ & 63, gw = vcu * NWAVES + __builtin_amdgcn_readfirstlane(tid_ >> 6);
    const pg8::u64* rowss = (const pg8::u64*)(a.ws + WS_CTL + CTL_ROWSS) + 8 * (size_t)M; const float* gn = a.in[4];
    f32x4 g[8];
#pragma unroll
    for (int j = 0; j < 4; ++j) { g[2 * j] = *((const f32x4*)gn + 2 * (64 * j + lane)); g[2 * j + 1] = *((const f32x4*)gn + 2 * (64 * j + lane) + 1); }
    const bf16* ab = (const bf16*)(a.ws + WS_AB);
    for (int m = gw; m < M; m += 2 * NGW) {
        const int m1 = (m + NGW < M) ? m + NGW : m;
        const GAS v4u* h0 = (const GAS v4u*)(ab + (size_t)m * DM) + lane; const GAS v4u* h1 = (const GAS v4u*)(ab + (size_t)m1 * DM) + lane;
        v4u w0[4], w1[4];
#pragma unroll
        for (int j = 0; j < 4; ++j) { w0[j] = h0[64 * j]; w1[j] = h1[64 * j]; }
        const float rs0 = 1.0f / sqrtf(pg8::rowss_get(rowss + m) * (1.0f / DM) + RMS_EPS), rs1 = 1.0f / sqrtf(pg8::rowss_get(rowss + m1) * (1.0f / DM) + RMS_EPS);
        GAS f32x4* x0 = (GAS f32x4*)(a.out + (size_t)m * DM) + 2 * lane; GAS f32x4* x1 = (GAS f32x4*)(a.out + (size_t)m1 * DM) + 2 * lane;
#pragma unroll
        for (int j = 0; j < 4; ++j) {
            { const v4u w = w0[j]; f32x4 lo, hi4; lo[0] = __builtin_bit_cast(float, w.x << 16); lo[1] = __builtin_bit_cast(float, w.x & 0xffff0000u); lo[2] = __builtin_bit_cast(float, w.y << 16); lo[3] = __builtin_bit_cast(float, w.y & 0xffff0000u);
              hi4[0] = __builtin_bit_cast(float, w.z << 16); hi4[1] = __builtin_bit_cast(float, w.z & 0xffff0000u); hi4[2] = __builtin_bit_cast(float, w.w << 16); hi4[3] = __builtin_bit_cast(float, w.w & 0xffff0000u);
              x0[128 * j] = lo * rs0 * g[2 * j]; x0[128 * j + 1] = hi4 * rs0 * g[2 * j + 1]; }
            if (m1 != m) { const v4u w = w1[j]; f32x4 lo, hi4; lo[0] = __builtin_bit_cast(float, w.x << 16); lo[1] = __builtin_bit_cast(float, w.x & 0xffff0000u); lo[2] = __builtin_bit_cast(float, w.y << 16); lo[3] = __builtin_bit_cast(float, w.y & 0xffff0000u);
              hi4[0] = __builtin_bit_cast(float, w.z << 16); hi4[1] = __builtin_bit_cast(float, w.z & 0xffff0000u); hi4[2] = __builtin_bit_cast(float, w.w << 16); hi4[3] = __builtin_bit_cast(float, w.w & 0xffff0000u);
              x1[128 * j] = lo * rs1 * g[2 * j]; x1[128 * j + 1] = hi4 * rs1 * g[2 * j + 1]; }
        }
    }
}

#ifndef WGM_G1
#define WGM_G1 4
#define WGM_UQ 4
#define WGM_WO 4
#define WGM_W1 4
#define WGM_W2 4
#endif
constexpr int PH_FINAL = 33, PH_END = 34;
__host__ __device__ __forceinline__ constexpr int ph_id(int L, int s) { return 1 + 8 * L + s; }

__global__ void __launch_bounds__(NWAVES * 64, 2) trunk_fwd(Args args) {
    extern __shared__ __attribute__((aligned(16))) unsigned char lds_raw[];
    LAS unsigned char* lds = (LAS unsigned char*)lds_raw;
    volatile LAS unsigned* MISC = (volatile LAS unsigned*)(lds + MISC_OFF);
    const int tid = threadIdx.x;
    const int G = gridDim.x; const int bx = blockIdx.x; const int vcu = (G % 8 == 0) ? (bx % 8) * (G / 8) + bx / 8 : bx;
    const int NGW = G * NWAVES;
    unsigned char* ws = args.ws;
    gu32* ctl = (gu32*)(ws + WS_CTL);
    for (int u = tid; u < (LDS_BYTES - LDSCTL_OFF) / 4; u += NWAVES * 64) ((LAS unsigned*)(lds + LDSCTL_OFF))[u] = 0u;
    __syncthreads();
    XcdBarrier bar = xcd_barrier_post((unsigned*)(ctl + CW_BAR) + args.li * XCD_BAR_WORDS, MISC + 8);
    const int lo = args.ph_lo, hi = args.ph_hi;
#define IN(k) (lo <= (k) && (k) < hi)
#define END_PHASE(k) do { if (hi > (k) + 1) xcd_barrier(bar); } while (0)

    bf16* abuf = (bf16*)(ws + WS_AB); bf16* obuf = (bf16*)(ws + WS_OB); unsigned char* big = ws + WS_BIG;

    if (IN(0)) { p0_prologue(args, lds, vcu, NGW); END_PHASE(0); }

    for (int L = 0; L < DEPTH; ++L) {
        const int type = L % 3, j = L / 3;
        const bool own_mix = ((args.skip_mix >> type) & 1) == 0;
        if (IN(ph_id(L, 0))) {
            pg8::EpiMulti E{}; E.rs_idx = 2 * L; E.inv_k = 1.0f / DM; E.ws = ws; E.qscale = 1.f;
            pg8::Gemm g; g.A = abuf; g.M = M; g.K = DM;
            if (type == 0)      { g.Bt = (const bf16*)(ws + W_SBQKV) + (size_t)j * 6144 * 2048; g.N = 6144; E.mode = pg8::EM_SBQKV; E.qscale = 0.08838834764831845f * LOG2E; }
            else if (type == 1) { g.Bt = (const bf16*)(ws + W_HGIN); g.N = 8192; E.mode = pg8::EM_HG; }
            else                { g.Bt = (const bf16*)(ws + W_DKV); g.N = MLA_DKV_NP; E.mode = pg8::EM_DKV; }
            pg8::StaticOrder S; S.init(M, g.N, G, bx, WGM_G1);
            pg8::gemm_phase<pg8::EpiMulti, pg8::StaticOrder, true, true>(lds + RING_OFF, g, S, E);
            END_PHASE(ph_id(L, 0));
        }
        if (type == 2 && IN(ph_id(L, 1))) {
            { pg8::EpiMulti E{}; E.mode = pg8::EM_UQ; E.rs_idx = RS_Q; E.inv_k = 1.0f / MLA_QR; E.ws = ws; E.qscale = 0.07216878364870322f * LOG2E;
              pg8::Gemm g; g.A = (const bf16*)(big + BIG_CQ); g.Bt = (const bf16*)(ws + W_UQ); g.M = M; g.N = 3072; g.K = MLA_QR;
              pg8::StaticOrder S; S.init(M, g.N, G, bx, WGM_UQ);
              pg8::gemm_phase<pg8::EpiMulti, pg8::StaticOrder, true, true>(lds + RING_OFF, g, S, E); }
            { pg8::EpiMulti E{}; E.mode = pg8::EM_UKV; E.rs_idx = RS_KV; E.inv_k = 1.0f / MLA_KVR; E.ws = ws; E.qscale = 1.f;
              pg8::Gemm g; g.A = (const bf16*)(big + BIG_CKV); g.Bt = (const bf16*)(ws + W_UKV); g.M = M; g.N = 4096; g.K = MLA_KVR;
              pg8::StaticOrder S; S.init(M, g.N, G, bx, WGM_UQ);
              pg8::gemm_phase<pg8::EpiMulti, pg8::StaticOrder, true, true>(lds + RING_OFF, g, S, E); }
            END_PHASE(ph_id(L, 1));
        }
        if (type == 0 && own_mix && IN(ph_id(L, 1))) {
            att::sb_phase((const bf16*)(big + BIG_QKV), obuf, lds + RING_OFF, vcu, G);
            END_PHASE(ph_id(L, 1));
        }
        if (type == 1 && own_mix) {
            if (IN(ph_id(L, 1))) { hg::pass_a((const bf16*)(big + BIG_HI), (const float*)(big + BIG_HLF), (bf16*)(big + BIG_HKVS), (float*)(big + BIG_HDEC), lds + RING_OFF, vcu, G); END_PHASE(ph_id(L, 1)); }
            if (IN(ph_id(L, 2))) { hg::pass_b((bf16*)(big + BIG_HKVS), (const float*)(big + BIG_HDEC), lds + RING_OFF, vcu, G); END_PHASE(ph_id(L, 2)); }
            if (IN(ph_id(L, 3))) { hg::pass_c((const bf16*)(big + BIG_HQ), (const bf16*)(big + BIG_HI), (const bf16*)(big + BIG_HG), (const float*)(big + BIG_HLF), (const bf16*)(big + BIG_HKVS), args.in[9], obuf, lds + RING_OFF, vcu, G);
                                   END_PHASE(ph_id(L, 3)); }
        }
        if (type == 2 && own_mix && IN(ph_id(L, 2))) {
            att::mla_phase((const bf16*)(big + BIG_QM), (const bf16*)(big + BIG_KVM), (const bf16*)(big + BIG_KPE), obuf, lds + RING_OFF, vcu, G);
            END_PHASE(ph_id(L, 2));
        }
        if (IN(ph_id(L, 4))) {
            pg8::Gemm g; g.A = obuf; g.M = M; g.N = DM; g.K = DM;
            g.Bt = (type == 0) ? (const bf16*)(ws + W_SBWO) + (size_t)j * 2048 * 2048 : (type == 1) ? (const bf16*)(ws + W_HGWO) : (const bf16*)(ws + W_MLAWO);
            pg8::EpiResid E{(L == 0) ? args.in[0] : nullptr, ws, 2 * L + 1};
            pg8::StaticOrder S; S.init(M, g.N, G, bx, WGM_WO);
            pg8::gemm_phase<pg8::EpiResid, pg8::StaticOrder, true, true>(lds + RING_OFF, g, S, E);
            END_PHASE(ph_id(L, 4));
        }
        if (IN(ph_id(L, 5))) {
            pg8::EpiMulti E{}; E.mode = pg8::EM_RELU2; E.rs_idx = 2 * L + 1; E.inv_k = 1.0f / DM; E.ws = ws; E.qscale = 1.f;
            pg8::Gemm g; g.A = abuf; g.Bt = (const bf16*)(ws + W_W1) + (size_t)L * 8192 * 2048; g.M = M; g.N = DFF; g.K = DM;
            pg8::StaticOrder S; S.init(M, g.N, G, bx, WGM_W1);
            pg8::gemm_phase<pg8::EpiMulti, pg8::StaticOrder, true, true>(lds + RING_OFF, g, S, E);
            END_PHASE(ph_id(L, 5));
        }
        if (IN(ph_id(L, 6))) {
            pg8::Gemm g; g.A = (const bf16*)(big + BIG_HID); g.Bt = (const bf16*)(ws + W_W2) + (size_t)L * 2048 * 8192; g.M = M; g.N = DM; g.K = DFF;
            pg8::EpiResid E{nullptr, ws, 2 * L + 2};
            pg8::StaticOrder S; S.init(M, g.N, G, bx, WGM_W2, 1);
            pg8::gemm_phase<pg8::EpiResid, pg8::StaticOrder, true, true>(lds + RING_OFF, g, S, E);
            END_PHASE(ph_id(L, 6));
        }
    }
    if (IN(PH_FINAL)) final_norm_phase(args, vcu, NGW);
#undef IN
#undef END_PHASE
}

extern "C" void kernel_launch(void* const* d_in, const int* in_sizes, int n_in, void* d_out, int out_size, void* d_ws, size_t ws_size, hipStream_t stream) {
    static int grid = 0;
    if (grid == 0) {
        if (n_in != 19 || in_sizes[0] != M * DM || out_size != M * DM || ws_size < WS_END) { fprintf(stderr, "kernel_launch: unexpected shapes (n_in %d, in0 %d, out %d, ws %zu < %zu)\n", n_in, n_in > 0 ? in_sizes[0] : -1, out_size, ws_size, (size_t)WS_END); grid = -1; return; }
        int dev = 0, cus = 0, per_cu = 0;
        if (hipGetDevice(&dev) != hipSuccess || hipDeviceGetAttribute(&cus, hipDeviceAttributeMultiprocessorCount, dev) != hipSuccess) { grid = -1; return; }
        if (hipFuncSetAttribute((const void*)trunk_fwd, hipFuncAttributeMaxDynamicSharedMemorySize, LDS_BYTES) != hipSuccess) { fprintf(stderr, "kernel_launch: hipFuncSetAttribute failed\n"); grid = -1; return; }
        if (hipOccupancyMaxActiveBlocksPerMultiprocessor(&per_cu, (const void*)trunk_fwd, NWAVES * 64, LDS_BYTES) != hipSuccess || per_cu < 1) fprintf(stderr, "kernel_launch: occupancy query says %d\n", per_cu);
        (void)hipGetLastError();
        grid = cus;
    }
    if (grid < 0) return;
    (void)hipMemsetAsync((char*)d_ws + WS_CTL, 0, CTL_ZERO_BYTES, stream);
    Args a{};
    for (int i = 0; i < 19; ++i) a.in[i] = (const float*)d_in[i];
    a.out = (float*)d_out; a.ws = (unsigned char*)d_ws;
    a.ph_lo = 0; a.ph_hi = PH_END; a.li = 0; a.skip_mix = 0;
    hipLaunchKernelGGL(trunk_fwd, dim3(grid), dim3(NWAVES * 64), LDS_BYTES, stream, a);
}
```

```cpp
#include <hip/hip_runtime.h>
#include <cstdio>
#include <cstdint>

constexpr int NWAVES = 8;
constexpr int BATCH = 2, SEQ = 8192, DM = 2048, DEPTH = 4, M = BATCH * SEQ;
constexpr int NH = 16, HD = 128, DFF = 8192;
constexpr int MLA_QR = 768, MLA_KVR = 512, MLA_ROPE = 64, MLA_NOPE = 128, MLA_QK = 192, MLA_DKV_N = 1344, MLA_DKV_NP = 2048;
constexpr int CHUNK = 64, NCHUNK = SEQ / CHUNK;
constexpr float RMS_EPS = 1e-6f;
constexpr float LOG2E = 1.4426950408889634f;

constexpr size_t MiB = 1u << 20;
constexpr size_t WS_CTL = 0, CTL_ZERO_BYTES = 2 * MiB;
constexpr int CW_TMO = 0, CW_BAR = 4096;
constexpr size_t CTL_ROWSS = 256 * 1024;
constexpr int RS_Q = 9, RS_KV = 10;
constexpr size_t WS_TAB = 2 * MiB;
constexpr size_t WS_CS = 3 * MiB;
constexpr size_t WS_W = 7 * MiB;
constexpr size_t W_SBQKV = WS_W;
constexpr size_t W_SBWO = W_SBQKV + 2 * (size_t)6144 * 2048 * 2;
constexpr size_t W_HGIN = W_SBWO + 2 * (size_t)2048 * 2048 * 2;
constexpr size_t W_HGWO = W_HGIN + (size_t)8192 * 2048 * 2;
constexpr size_t W_DKV = W_HGWO + (size_t)2048 * 2048 * 2;
constexpr size_t W_UQ = W_DKV + (size_t)2048 * 2048 * 2;
constexpr size_t W_UKV = W_UQ + (size_t)3072 * 768 * 2;
constexpr size_t W_MLAWO = W_UKV + (size_t)4096 * 512 * 2;
constexpr size_t W_W1 = W_MLAWO + (size_t)2048 * 2048 * 2;
constexpr size_t W_W2 = W_W1 + 4 * (size_t)8192 * 2048 * 2;
constexpr size_t W_END = W_W2 + 4 * (size_t)8192 * 2048 * 2;
constexpr size_t WS_AB = 392 * MiB;
constexpr size_t WS_OB = WS_AB + 64 * MiB;
constexpr size_t WS_BIG = WS_OB + 64 * MiB;
static_assert(W_END <= WS_AB, "weights fit");
constexpr size_t BIG_QKV = 0;
constexpr size_t BIG_HID = 0;
constexpr size_t BIG_HQ = 0, BIG_HI = 64 * MiB, BIG_HG = 128 * MiB, BIG_HLF = 192 * MiB, BIG_HKVS = 320 * MiB;
constexpr size_t BIG_HDEC = 448 * MiB;
constexpr size_t BIG_CQ = 0, BIG_CKV = 24 * MiB, BIG_KPE = 40 * MiB, BIG_QM = 48 * MiB, BIG_KVM = 144 * MiB;
constexpr size_t WS_END = WS_BIG + 452 * MiB;
static_assert(WS_END <= (size_t)1024 * MiB, "workspace map inside 1 GiB");

constexpr int RING_OFF = 0, RING_BYTES = 131072;
constexpr int LDSCTL_OFF = RING_BYTES, MISC_OFF = LDSCTL_OFF + 320;
constexpr int LDS_BYTES = 147456;

namespace pg8 {
#define PG8_LAS __attribute__((address_space(3)))
typedef unsigned short bf16_t;
typedef short bf16x8 __attribute__((ext_vector_type(8)));
typedef float f32x4 __attribute__((ext_vector_type(4)));
typedef unsigned u32x4 __attribute__((ext_vector_type(4)));
constexpr int BM = 256, BK = 64, HALF = 128, HTB = HALF * BK * 2  , STAGE_BYTES = 8 * HTB, NXCD = 8;

__host__ __device__ __forceinline__ int lds_byte(int r, int c) { const int st = (r >> 4) * 2 + (c >> 5), rr = r & 15, cc = c & 31, ob = rr * 64 + cc * 2; return st * 1024 + (ob ^ (((ob >> 9) & 1) << 5)); }
__host__ __device__ __forceinline__ void stage_rc(int b, int& R, int& C) { const int st = b / 1024, sb = b % 1024, swz = sb ^ (((sb >> 9) & 1) << 5); R = (st >> 1) * 16 + swz / 64; C = (st & 1) * 32 + (swz % 64) / 2; }
__host__ __device__ __forceinline__ int perm32(int rho) { const int n = rho >> 4, i = rho & 15; return 8 * (i >> 2) + 4 * n + (i & 3); }

struct Unit { int pm, pn; };
struct Gemm { const bf16_t* A; const bf16_t* Bt; int M, N, K; };

struct StaticOrder {
    int nM, nN, nwg, G, c, WGM, rev;
    __host__ __device__ void init(int M, int N, int G_, int c_, int wgm = 4, int rev_ = 0) { nM = M / BM; nN = N / BM; nwg = nM * nN; G = G_; c = c_; WGM = wgm; rev = rev_; }
    __host__ __device__ bool next(int i, Unit& u) const {
        const long L = (long)i * G + c; if (L >= nwg) return false;
        int wgid = (int)L; { const int q = nwg / NXCD, r = nwg % NXCD, xcd = wgid % NXCD, off = wgid / NXCD; wgid = (xcd < r ? xcd * (q + 1) : r * (q + 1) + (xcd - r) * q) + off; }
        const int nig = WGM * nN, gid = wgid / nig, fm = gid * WGM, gsz = (nM - fm) < WGM ? (nM - fm) : WGM;
        u.pm = fm + ((wgid % nig) % gsz); u.pn = (wgid % nig) / gsz; if (rev) u.pm = nM - 1 - u.pm; return true;
    }
    __device__ __forceinline__ void a_ready(const Unit&) const {}
    __device__ __forceinline__ void done(const Unit&) const {}
};
__device__ __forceinline__ unsigned cvt_pk_bf16(float lo, float hi) { unsigned r; asm volatile("v_cvt_pk_bf16_f32 %0, %1, %2" : "=v"(r) : "v"(lo), "v"(hi)); return r; }
constexpr size_t KWS_AB = WS_AB, KCTL_ROWSS = WS_CTL + CTL_ROWSS, KWS_BIG = WS_BIG, KWS_CS = WS_CS, KWS_TAB = WS_TAB, KM = M;
constexpr size_t KBIG_QKV = BIG_QKV, KBIG_HID = BIG_HID, KBIG_HQ = BIG_HQ, KBIG_HI = BIG_HI, KBIG_HG = BIG_HG, KBIG_HLF = BIG_HLF, KBIG_CQ = BIG_CQ, KBIG_CKV = BIG_CKV, KBIG_KPE = BIG_KPE, KBIG_QM = BIG_QM, KBIG_KVM = BIG_KVM;
__device__ __forceinline__ u32x4 pack8_bf16(const f32x4 a, const f32x4 b) { u32x4 w; w.x = cvt_pk_bf16(a[0], a[1]); w.y = cvt_pk_bf16(a[2], a[3]); w.z = cvt_pk_bf16(b[0], b[1]); w.w = cvt_pk_bf16(b[2], b[3]); return w; }
__device__ __forceinline__ float dot4(const f32x4 a) { return (a[0] * a[0] + a[1] * a[1]) + (a[2] * a[2] + a[3] * a[3]); }
typedef unsigned long long u64;
constexpr double RSS_FIX = 16777216.0;
__device__ __forceinline__ void rowss_add(u64* p, float v) {
    const float hf = floorf(v * 0.00390625f); const float rem = fmaf(-256.0f, hf, v);
    const u64 q = ((u64)(unsigned)hf << 32) | (u64)(unsigned)(rem * 16777216.0f);
    const u64 old = __hip_atomic_fetch_add(p, q, __ATOMIC_RELAXED, __HIP_MEMORY_SCOPE_AGENT);
    asm volatile("" :: "v"(old));
}
__device__ __forceinline__ float rowss_cvt(u64 v) { return (float)((double)(long long)v * (1.0 / RSS_FIX)); }
__device__ __forceinline__ float rowss_get(const u64* p) { return rowss_cvt(*p); }
__device__ __forceinline__ float rowss_rs(u64 v, float inv_k) { const float f = (float)(unsigned)(v >> 32) * 256.0f + (float)(unsigned)v * (float)(1.0 / RSS_FIX); return __builtin_amdgcn_rsqf(f * inv_k + 1e-6f); }

__device__ __forceinline__ float quad16_sum(float v) {
    { const unsigned u = __builtin_bit_cast(unsigned, v); auto r = __builtin_amdgcn_permlane16_swap(u, u, false, false); v = __builtin_bit_cast(float, (unsigned)r[0]) + __builtin_bit_cast(float, (unsigned)r[1]); }
    { const unsigned u = __builtin_bit_cast(unsigned, v); auto r = __builtin_amdgcn_permlane32_swap(u, u, false, false); v = __builtin_bit_cast(float, (unsigned)r[0]) + __builtin_bit_cast(float, (unsigned)r[1]); }
    return v;
}
__device__ __forceinline__ f32x4 bf16x4_lo(const u32x4 w, int half) { f32x4 r; const unsigned a = half ? w.z : w.x, b = half ? w.w : w.y;
    r[0] = __builtin_bit_cast(float, a << 16); r[1] = __builtin_bit_cast(float, a & 0xffff0000u); r[2] = __builtin_bit_cast(float, b << 16); r[3] = __builtin_bit_cast(float, b & 0xffff0000u); return r; }
struct EpiResid {
    static constexpr bool PERM = true, AFTER_DRAIN = false;
    const float* x0; unsigned char* ws; int rs_idx;
    struct Pref {};
    __device__ __forceinline__ void prefetch(const Unit&, int, int, Pref&) const {}
    __device__ __forceinline__ void operator()(const f32x4 (&acc)[2][2][4][2], const Unit& u, int wr, int wc, int fr, int fq, const Pref&) const {
        const int row0 = u.pm * BM + wr * 64 + fr, col0 = u.pn * BM + wc * 32 + 8 * fq;
        bf16_t* ab = (bf16_t*)(ws + KWS_AB); u64* rowss = (u64*)(ws + KCTL_ROWSS) + (size_t)rs_idx * KM;
        if (x0) {
#pragma unroll
            for (int ai = 0; ai < 2; ++ai) {
                f32x4 r[4][2][2];
#pragma unroll
                for (int m = 0; m < 4; ++m)
#pragma unroll
                    for (int bj = 0; bj < 2; ++bj) { const float* p = x0 + (size_t)(row0 + ai * HALF + m * 16) * 2048 + col0 + bj * HALF; r[m][bj][0] = *(const f32x4*)p; r[m][bj][1] = *(const f32x4*)(p + 4); }
#pragma unroll
                for (int m = 0; m < 4; ++m) {
                    const int row = row0 + ai * HALF + m * 16; const size_t off = (size_t)row * 2048 + col0; float ss = 0.f;
#pragma unroll
                    for (int bj = 0; bj < 2; ++bj) {
                        const f32x4 v0 = r[m][bj][0] + acc[ai][bj][m][0], v1 = r[m][bj][1] + acc[ai][bj][m][1];
                        ss += dot4(v0) + dot4(v1);
                        *(u32x4*)(ab + off + bj * HALF) = pack8_bf16(v0, v1);
                    }
                    ss = quad16_sum(ss);
                    if (fq == 0) rowss_add(rowss + row, ss);
                }
                asm volatile("" ::: "memory");
            }
        } else {
            u32x4 w[2][4][2];
#pragma unroll
            for (int ai = 0; ai < 2; ++ai)
#pragma unroll
                for (int m = 0; m < 4; ++m)
#pragma unroll
                    for (int bj = 0; bj < 2; ++bj) w[ai][m][bj] = *(const u32x4*)(ab + (size_t)(row0 + ai * HALF + m * 16) * 2048 + col0 + bj * HALF);
#pragma unroll
            for (int ai = 0; ai < 2; ++ai)
#pragma unroll
                for (int m = 0; m < 4; ++m) {
                    const int row = row0 + ai * HALF + m * 16; const size_t off = (size_t)row * 2048 + col0; float ss = 0.f;
#pragma unroll
                    for (int bj = 0; bj < 2; ++bj) {
                        const f32x4 v0 = bf16x4_lo(w[ai][m][bj], 0) + acc[ai][bj][m][0], v1 = bf16x4_lo(w[ai][m][bj], 1) + acc[ai][bj][m][1];
                        ss += dot4(v0) + dot4(v1);
                        *(u32x4*)(ab + off + bj * HALF) = pack8_bf16(v0, v1);
                    }
                    ss = quad16_sum(ss);
                    if (fq == 0) rowss_add(rowss + row, ss);
                }
        }
    }
};

enum { EM_SBQKV = 0, EM_RELU2 = 1, EM_HG = 2, EM_DKV = 3, EM_UQ = 4, EM_UKV = 5 };
struct EpiMulti {
    static constexpr bool PERM = true, AFTER_DRAIN = false;
    int mode, rs_idx; float inv_k, qscale; unsigned char* ws;
    struct Pref { u64 v[2][4]; };
    __device__ __forceinline__ void prefetch(const Unit& u, int wr, int fr, Pref& p) const {
        const u64* r = (const u64*)(ws + KCTL_ROWSS) + (size_t)rs_idx * KM + u.pm * BM + wr * 64 + fr;
#pragma unroll
        for (int ai = 0; ai < 2; ++ai)
#pragma unroll
            for (int m = 0; m < 4; ++m) p.v[ai][m] = r[ai * HALF + m * 16];
    }
    __device__ __forceinline__ void operator()(const f32x4 (&acc)[2][2][4][2], const Unit& u, int wr, int wc, int fr, int fq, const Pref& pf) const {
        const int row0 = u.pm * BM + wr * 64 + fr, colt = u.pn * BM, lc = wc * 32 + 8 * fq;
        unsigned char* big = ws + KWS_BIG; const float* cs = (const float*)(ws + KWS_CS);
#pragma unroll
        for (int ai = 0; ai < 2; ++ai)
#pragma unroll
            for (int m = 0; m < 4; ++m) {
                const int row = row0 + ai * HALF + m * 16;
                const float rs = rowss_rs(pf.v[ai][m], inv_k);
                float ss = 0.f;
#pragma unroll
                for (int bj = 0; bj < 2; ++bj) {
                    f32x4 v0 = acc[ai][bj][m][0] * rs, v1 = acc[ai][bj][m][1] * rs;
                    const int col = colt + bj * HALF + lc;
                    if (mode == EM_SBQKV) {
                        if (col < 2048) { v0 = v0 * qscale; v1 = v1 * qscale; }
                        *(u32x4*)((bf16_t*)(big + KBIG_QKV) + (size_t)row * 6144 + col) = pack8_bf16(v0, v1);
                    } else if (mode == EM_RELU2) {
#pragma unroll
                        for (int e = 0; e < 4; ++e) { v0[e] = fmaxf(v0[e], 0.f); v1[e] = fmaxf(v1[e], 0.f); }
                        v0 = v0 * v0; v1 = v1 * v1;
                        *(u32x4*)((bf16_t*)(big + KBIG_HID) + (size_t)row * 8192 + col) = pack8_bf16(v0, v1);
                    } else if (mode == EM_HG) {
                        const int t = col >> 11, c = col & 2047;
                        if (t == 1) {
                            const float* lbt = (const float*)(ws + KWS_TAB) + 4096; const float* omlt = lbt + 2048;
                            const f32x4 la0 = *(const f32x4*)(lbt + c), la1 = *(const f32x4*)(lbt + c + 4), lm0 = *(const f32x4*)(omlt + c), lm1 = *(const f32x4*)(omlt + c + 4);
                            f32x4 o0, o1;
#pragma unroll
                            for (int e = 0; e < 4; ++e) {
                                o0[e] = __logf(fmaf(lm0[e], __builtin_amdgcn_rcpf(1.f + __expf(-v0[e])), la0[e]));
                                o1[e] = __logf(fmaf(lm1[e], __builtin_amdgcn_rcpf(1.f + __expf(-v1[e])), la1[e]));
                            }
                            float* lf = (float*)(big + KBIG_HLF); *(f32x4*)(lf + (size_t)row * 2048 + c) = o0; *(f32x4*)(lf + (size_t)row * 2048 + c + 4) = o1;
                        } else {
                            bf16_t* dst = (bf16_t*)(big + ((t == 0) ? KBIG_HQ : (t == 2) ? KBIG_HI : KBIG_HG));
                            *(u32x4*)(dst + (size_t)row * 2048 + c) = pack8_bf16(v0, v1);
                        }
                    } else if (mode == EM_DKV) {
                        if (col < 768) { ss += dot4(v0) + dot4(v1); *(u32x4*)((bf16_t*)(big + KBIG_CQ) + (size_t)row * 768 + col) = pack8_bf16(v0, v1); }
                        else if (col < 1280) { ss += dot4(v0) + dot4(v1); *(u32x4*)((bf16_t*)(big + KBIG_CKV) + (size_t)row * 512 + (col - 768)) = pack8_bf16(v0, v1); }
                        else if (col < 1344) {
                            const int i0 = (col - 1280) >> 1;
                            const f32x4 c0 = *(const f32x4*)(cs + (size_t)row * 64 + 2 * i0), c1 = *(const f32x4*)(cs + (size_t)row * 64 + 2 * i0 + 4);
                            f32x4 o0, o1;
                            o0[0] = v0[0] * c0[0] - v0[1] * c0[1]; o0[1] = v0[0] * c0[1] + v0[1] * c0[0]; o0[2] = v0[2] * c0[2] - v0[3] * c0[3]; o0[3] = v0[2] * c0[3] + v0[3] * c0[2];
                            o1[0] = v1[0] * c1[0] - v1[1] * c1[1]; o1[1] = v1[0] * c1[1] + v1[1] * c1[0]; o1[2] = v1[2] * c1[2] - v1[3] * c1[3]; o1[3] = v1[2] * c1[3] + v1[3] * c1[2];
                            *(u32x4*)((bf16_t*)(big + KBIG_KPE) + (size_t)row * 64 + (col - 1280)) = pack8_bf16(o0, o1);
                        }
                    } else if (mode == EM_UQ) {
                        v0 = v0 * qscale; v1 = v1 * qscale;
                        const int cc = col % 192;
                        if (cc >= 128) {
                            const int i0 = (cc - 128) >> 1;
                            const f32x4 c0 = *(const f32x4*)(cs + (size_t)row * 64 + 2 * i0), c1 = *(const f32x4*)(cs + (size_t)row * 64 + 2 * i0 + 4);
                            f32x4 o0, o1;
                            o0[0] = v0[0] * c0[0] - v0[1] * c0[1]; o0[1] = v0[0] * c0[1] + v0[1] * c0[0]; o0[2] = v0[2] * c0[2] - v0[3] * c0[3]; o0[3] = v0[2] * c0[3] + v0[3] * c0[2];
                            o1[0] = v1[0] * c1[0] - v1[1] * c1[1]; o1[1] = v1[0] * c1[1] + v1[1] * c1[0]; o1[2] = v1[2] * c1[2] - v1[3] * c1[3]; o1[3] = v1[2] * c1[3] + v1[3] * c1[2];
                            v0 = o0; v1 = o1;
                        }
                        *(u32x4*)((bf16_t*)(big + KBIG_QM) + (size_t)row * 3072 + col) = pack8_bf16(v0, v1);
                    } else {
                        *(u32x4*)((bf16_t*)(big + KBIG_KVM) + (size_t)row * 4096 + col) = pack8_bf16(v0, v1);
                    }
                }
                if (mode == EM_DKV && colt < 1280) {
                    ss = quad16_sum(ss);
                    if (fq == 0) rowss_add((u64*)(ws + KCTL_ROWSS) + (size_t)(colt < 768 ? 9 : 10) * KM + row, ss);
                }
                if (m & 1) asm volatile("" ::: "memory");
            }
    }
};
template <class Epi, class Sched, bool ALIGN_EPI = false, bool SP2 = false>
__device__ __forceinline__ void gemm_phase(PG8_LAS unsigned char* lds, const Gemm g, const Sched& S, const Epi& E) {
    int tid_ = threadIdx.x; asm volatile("" : "+v"(tid_));
    const int tid = tid_, wid = __builtin_amdgcn_readfirstlane(tid >> 6), lane = tid & 63, wr = wid >> 2, wc = wid & 3, fr = lane & 15, fq = lane >> 4;
    const int K = g.K, nt = K / BK;
    unsigned voffA[2], voffB[2];
#pragma unroll
    for (int i = 0; i < 2; ++i) { int R, C; stage_rc(tid * 16 + i * 8192, R, C); const int Rb = Epi::PERM ? ((R & ~31) + perm32(R & 31)) : R;
        voffA[i] = (unsigned)(R * K + C) * 2u; voffB[i] = (unsigned)(Rb * K + C) * 2u; }
    const size_t kstep = (size_t)(BK * 2);
    const size_t hstep = (size_t)HALF * K * 2;
    const size_t tstep = 2 * hstep;
    const unsigned ldsw = (unsigned)wid * 1024u;
    const int aoff = lds_byte(wr * 64 + fr, fq * 8), boff = lds_byte(wc * 32 + fr, fq * 8);
#define PG8_SA(b, h) (((b) * 2 + (h)) * HTB)
#define PG8_SB(b, h) ((4 + (b) * 2 + (h)) * HTB)
#define PG8_STAGE(bufoff, gbase, voff) do { const char* gb_ = (const char*)(gbase); asm volatile("" : "+s"(gb_));     \
        _Pragma("unroll") for (int _i = 0; _i < 2; ++_i) { unsigned vo_ = (voff)[_i]; asm volatile("" : "+v"(vo_)); \
        __builtin_amdgcn_global_load_lds((const unsigned*)(gb_ + vo_), (PG8_LAS unsigned*)(lds + (bufoff) + ldsw + _i * 8192), 16, 0, 0); } } while (0)
#define PG8_LDA(dst, b, h) do { _Pragma("unroll") for (int m = 0; m < 4; ++m) _Pragma("unroll") for (int k = 0; k < 2; ++k) dst[m][k] = *(const PG8_LAS bf16x8*)(lds + PG8_SA(b, h) + aoff + m * 2048 + k * 1024); } while (0)
#define PG8_LDB(dst, b, h) do { _Pragma("unroll") for (int n = 0; n < 2; ++n) _Pragma("unroll") for (int k = 0; k < 2; ++k) dst[n][k] = *(const PG8_LAS bf16x8*)(lds + PG8_SB(b, h) + boff + n * 2048 + k * 1024); } while (0)
#define PG8_MMA(ai, bj, At, Bt) do { __builtin_amdgcn_s_setprio(1); _Pragma("unroll") for (int m = 0; m < 4; ++m) _Pragma("unroll") for (int n = 0; n < 2; ++n) _Pragma("unroll") for (int k = 0; k < 2; ++k) \
        acc[ai][bj][m][n] = __builtin_amdgcn_mfma_f32_16x16x32_bf16(Bt[n][k], At[m][k], acc[ai][bj][m][n], 0, 0, 0); __builtin_amdgcn_s_setprio(0); } while (0)
#define PG8_WAIT_V(n) asm volatile("s_waitcnt vmcnt(" #n ")" ::: "memory")
#define PG8_WAIT_L(n) asm volatile("s_waitcnt lgkmcnt(" #n ")" ::: "memory")
#define PG8_BAR __builtin_amdgcn_s_barrier()
#define PG8_SCHED __builtin_amdgcn_sched_barrier(0)
    Unit cur, nxt; int ui = 0;
    if (!S.next(0, cur)) return;
    f32x4 acc[2][2][4][2];
#pragma unroll
    for (int a = 0; a < 2; ++a)
#pragma unroll
        for (int b = 0; b < 2; ++b)
#pragma unroll
            for (int m = 0; m < 4; ++m)
#pragma unroll
                for (int n = 0; n < 2; ++n) acc[a][b][m][n] = (f32x4){0.f, 0.f, 0.f, 0.f};
    bf16x8 At[4][2], B0[2][2], B1[2][2];
    const char* cA = (const char*)g.A + (size_t)cur.pm * tstep; const char* cB = (const char*)g.Bt + (size_t)cur.pn * tstep;
    S.a_ready(cur);
    typename Epi::Pref pf; E.prefetch(cur, wr, fr, pf);
    if constexpr (SP2) {
        PG8_STAGE(PG8_SB(0, 0), cB, voffB); PG8_STAGE(PG8_SB(0, 1), cB + hstep, voffB); PG8_STAGE(PG8_SA(0, 0), cA, voffA); PG8_STAGE(PG8_SA(0, 1), cA + hstep, voffA);
        if (wr == 1) PG8_BAR;
        PG8_WAIT_V(2); PG8_BAR;
        PG8_STAGE(PG8_SB(1, 0), cB + kstep, voffB); PG8_STAGE(PG8_SA(1, 0), cA + kstep, voffA); PG8_STAGE(PG8_SB(1, 1), cB + hstep + kstep, voffB);
        PG8_WAIT_V(6); PG8_BAR;
    } else {
        PG8_STAGE(PG8_SB(0, 0), cB, voffB); PG8_STAGE(PG8_SA(0, 0), cA, voffA); PG8_STAGE(PG8_SB(0, 1), cB + hstep, voffB); PG8_STAGE(PG8_SA(0, 1), cA + hstep, voffA);
        if (wr == 1) PG8_BAR;
        PG8_WAIT_V(4); PG8_BAR;
        PG8_STAGE(PG8_SB(1, 0), cB + kstep, voffB); PG8_STAGE(PG8_SA(1, 0), cA + kstep, voffA); PG8_STAGE(PG8_SB(1, 1), cB + hstep + kstep, voffB);
        PG8_WAIT_V(6); PG8_BAR;
    }
    for (;;) {
        const bool has_next = S.next(ui + 1, nxt);
        const char* nA = has_next ? (const char*)g.A + (size_t)nxt.pm * tstep : cA; const char* nB = has_next ? (const char*)g.Bt + (size_t)nxt.pn * tstep : cB;
        for (int t = 0; t < nt; t += 2) {
            const bool last = (t == nt - 2);
            const char* a1 = cA + (size_t)(t + 1) * kstep;
            const char* a2 = last ? nA : cA + (size_t)(t + 2) * kstep; const char* b2 = last ? nB : cB + (size_t)(t + 2) * kstep;
            const char* a3 = a2 + kstep; const char* b3 = b2 + kstep;
            if (last && has_next) S.a_ready(nxt);
            if constexpr (SP2) {
            PG8_LDB(B0, 0, 0); PG8_LDB(B1, 0, 1); PG8_SCHED; PG8_LDA(At, 0, 0); PG8_STAGE(PG8_SA(1, 1), a1 + hstep, voffA);
            PG8_WAIT_V(8); PG8_WAIT_L(0); PG8_BAR; PG8_MMA(0, 0, At, B0); PG8_MMA(0, 1, At, B1); PG8_BAR; PG8_SCHED;
            PG8_LDA(At, 0, 1); PG8_STAGE(PG8_SB(0, 0), b2, voffB); PG8_STAGE(PG8_SB(0, 1), b2 + hstep, voffB); PG8_STAGE(PG8_SA(0, 0), a2, voffA);
            PG8_WAIT_V(8); PG8_WAIT_L(0); PG8_BAR; PG8_MMA(1, 0, At, B0); PG8_MMA(1, 1, At, B1); PG8_BAR; PG8_SCHED;
            PG8_LDB(B0, 1, 0); PG8_LDB(B1, 1, 1); PG8_SCHED; PG8_LDA(At, 1, 0); PG8_STAGE(PG8_SA(0, 1), a2 + hstep, voffA);
            PG8_WAIT_V(8); PG8_WAIT_L(0); PG8_BAR; PG8_MMA(0, 0, At, B0); PG8_MMA(0, 1, At, B1); PG8_BAR; PG8_SCHED;
            PG8_LDA(At, 1, 1); PG8_STAGE(PG8_SB(1, 0), b3, voffB); PG8_STAGE(PG8_SB(1, 1), b3 + hstep, voffB); PG8_STAGE(PG8_SA(1, 0), a3, voffA);
            PG8_WAIT_V(8); PG8_WAIT_L(0); PG8_BAR; PG8_MMA(1, 0, At, B0); PG8_MMA(1, 1, At, B1); PG8_BAR; PG8_SCHED;
            } else {
            PG8_LDB(B0, 0, 0); PG8_SCHED; PG8_LDA(At, 0, 0); PG8_STAGE(PG8_SA(1, 1), a1 + hstep, voffA);
            PG8_WAIT_L(8); PG8_BAR; PG8_WAIT_L(0); PG8_MMA(0, 0, At, B0); PG8_BAR; PG8_SCHED;
            PG8_LDB(B1, 0, 1); PG8_STAGE(PG8_SB(0, 0), b2, voffB);
            PG8_BAR; PG8_WAIT_L(0); PG8_MMA(0, 1, At, B1); PG8_BAR;
            PG8_LDA(At, 0, 1); PG8_STAGE(PG8_SA(0, 0), a2, voffA);
            PG8_BAR; PG8_WAIT_L(0); PG8_MMA(1, 0, At, B0); PG8_BAR; PG8_SCHED;
            PG8_STAGE(PG8_SB(0, 1), b2 + hstep, voffB);
            PG8_WAIT_V(6); PG8_BAR; PG8_MMA(1, 1, At, B1); PG8_BAR;
            PG8_LDB(B0, 1, 0); PG8_SCHED; PG8_LDA(At, 1, 0); PG8_STAGE(PG8_SA(0, 1), a2 + hstep, voffA);
            PG8_WAIT_L(8); PG8_BAR; PG8_WAIT_L(0); PG8_MMA(0, 0, At, B0); PG8_BAR; PG8_SCHED;
            PG8_LDB(B1, 1, 1); PG8_STAGE(PG8_SB(1, 0), b3, voffB);
            PG8_BAR; PG8_WAIT_L(0); PG8_MMA(0, 1, At, B1); PG8_BAR;
            PG8_LDA(At, 1, 1); PG8_STAGE(PG8_SA(1, 0), a3, voffA);
            PG8_BAR; PG8_WAIT_L(0); PG8_MMA(1, 0, At, B0); PG8_BAR; PG8_SCHED;
            PG8_STAGE(PG8_SB(1, 1), b3 + hstep, voffB);
            PG8_WAIT_V(6); PG8_BAR; PG8_MMA(1, 1, At, B1); PG8_BAR;
            }
        }
        if constexpr (ALIGN_EPI) { if (wr == 0) PG8_BAR; }
        if constexpr (!Epi::AFTER_DRAIN) { E(acc, cur, wr, wc, fr, fq, pf); S.done(cur); }
        if (!has_next) break;
#pragma unroll
        for (int a = 0; a < 2; ++a)
#pragma unroll
            for (int b = 0; b < 2; ++b)
#pragma unroll
                for (int m = 0; m < 4; ++m)
#pragma unroll
                    for (int n = 0; n < 2; ++n) acc[a][b][m][n] = (f32x4){0.f, 0.f, 0.f, 0.f};
        cur = nxt; cA = nA; cB = nB; ++ui;
        E.prefetch(cur, wr, fr, pf);
        if constexpr (ALIGN_EPI) { if (wr == 1) PG8_BAR; }
    }
    PG8_WAIT_V(0);
    if constexpr (!ALIGN_EPI) { if (wr == 0) PG8_BAR; }
    PG8_BAR;
    if constexpr (Epi::AFTER_DRAIN) { E.fused(acc, cur, wr, wc, fr, fq, lds, wid, lane); S.done(cur); }
#undef PG8_SA
#undef PG8_SB
#undef PG8_STAGE
#undef PG8_LDA
#undef PG8_LDB
#undef PG8_MMA
#undef PG8_WAIT_V
#undef PG8_WAIT_L
#undef PG8_BAR
#undef PG8_SCHED
}
}

#define GAS __attribute__((address_space(1)))
#define LAS __attribute__((address_space(3)))
typedef unsigned short bf16;
typedef unsigned v4u __attribute__((ext_vector_type(4)));
typedef unsigned v2u __attribute__((ext_vector_type(2)));
typedef float f32x4 __attribute__((ext_vector_type(4)));
typedef float f32x2 __attribute__((ext_vector_type(2)));
typedef short bf16x8 __attribute__((ext_vector_type(8)));
typedef GAS unsigned gu32;
#define RLX_AGENT __ATOMIC_RELAXED, __HIP_MEMORY_SCOPE_AGENT
#define LDS_WAIT() asm volatile("s_waitcnt lgkmcnt(0)" ::: "memory")
#define VM_WAIT() asm volatile("s_waitcnt vmcnt(0)" ::: "memory")
__device__ __forceinline__ unsigned pk2(float lo, float hi) { unsigned r; asm("v_cvt_pk_bf16_f32 %0, %1, %2" : "=v"(r) : "v"(lo), "v"(hi)); return r; }
__device__ __forceinline__ unsigned f2bf(float f) { return pk2(f, f) & 0xffffu; }
__device__ __forceinline__ float bf2f(unsigned short h) { return __builtin_bit_cast(float, (unsigned)h << 16); }
__device__ __forceinline__ float wave_sum(float v) {
#pragma unroll
    for (int o = 1; o < 64; o <<= 1) v += __shfl_xor(v, o);
    return v;
}
__device__ __forceinline__ float wave_max(float v) {
#pragma unroll
    for (int o = 1; o < 64; o <<= 1) v = fmaxf(v, __shfl_xor(v, o));
    return v;
}
#define XB_TMO      128
#define XB_XCNT(j)  (256  + 64 * (j))
#define XB_XSUB(j)  (1280 + 64 * (j))
#define XB_XGEN(j)  (2304 + 64 * (j))
#define XB_TOP      3328
#define XB_TOPGEN   3392
#define XCD_BAR_WORDS 3456
#define XB_SPIN_CAP (1u << 18)

__device__ __forceinline__ unsigned xb_ld(unsigned* p)              { return __hip_atomic_load(p, __ATOMIC_RELAXED, __HIP_MEMORY_SCOPE_AGENT); }
__device__ __forceinline__ unsigned xb_add(unsigned* p, unsigned v) { return __hip_atomic_fetch_add(p, v, __ATOMIC_RELAXED, __HIP_MEMORY_SCOPE_AGENT); }
__device__ __forceinline__ unsigned xb_xcc_id() { return (unsigned)__builtin_amdgcn_s_getreg((3 << 11) | 20) & 0xFu; }
#define XB_SPIN(cond, bar) do { unsigned _sp = 0; while (cond) { __builtin_amdgcn_s_sleep(1); \
    if ((++_sp & 255u) == 0u) { if (xb_ld(&(bar)[XB_TMO])) break; if (_sp > XB_SPIN_CAP) { atomicAdd(&(bar)[XB_TMO], 1u); break; } } } } while (0)

struct XcdBarrier {
    unsigned* bar; unsigned x;
    volatile LAS unsigned* st;
};

__device__ __forceinline__ XcdBarrier xcd_barrier_post(unsigned* bar, volatile LAS unsigned* st) {
    XcdBarrier b; b.bar = bar; b.x = xb_xcc_id(); b.st = st;
    if (threadIdx.x == 0) (void)xb_add(&bar[XB_XCNT(b.x)], 1u);
    return b;
}
__device__ __forceinline__ void xcd_barrier_complete(unsigned* bar, unsigned x, unsigned& nloc, unsigned& nx) {
    const unsigned G = gridDim.x * gridDim.y * gridDim.z;
    unsigned sum, cnt, mine, sp = 0u;
    for (;;) {
        sum = 0u; cnt = 0u; mine = 0u;
#pragma unroll
        for (unsigned j = 0; j < 16; ++j) { const unsigned c = xb_ld(&bar[XB_XCNT(j)]); sum += c; cnt += (c > 0u) ? 1u : 0u; mine = (j == x) ? c : mine; }
        if (sum == G) break;
        __builtin_amdgcn_s_sleep(1);
        if ((++sp & 255u) == 0u) { if (xb_ld(&bar[XB_TMO])) break; if (sp > XB_SPIN_CAP) { atomicAdd(&bar[XB_TMO], 1u); break; } }
    }
    nloc = mine > 0u ? mine : 1u; nx = cnt > 0u ? cnt : 1u;
}

__device__ __forceinline__ void xcd_barrier(const XcdBarrier& b) {
    asm volatile("s_waitcnt vmcnt(0)" ::: "memory");
    __syncthreads();
    if (threadIdx.x == 0) {
        unsigned* bar = b.bar;
        __builtin_amdgcn_s_waitcnt(0);
        unsigned nloc = b.st[0], nx = b.st[1];
        if (nloc == 0u) { xcd_barrier_complete(bar, b.x, nloc, nx); b.st[0] = nloc; b.st[1] = nx; }
        const unsigned old = xb_add(&bar[XB_XSUB(b.x)], 1u);
        const unsigned gen = old / nloc;
        if (old + 1u == (gen + 1u) * nloc) {
            __builtin_amdgcn_fence(__ATOMIC_RELEASE, "agent");
            asm volatile("s_waitcnt vmcnt(0)" ::: "memory");
            const unsigned og = xb_add(&bar[XB_TOP], 1u);
            const unsigned tg = og / nx;
            if (og + 1u == (tg + 1u) * nx) xb_add(&bar[XB_TOPGEN], 1u);
            else XB_SPIN(xb_ld(&bar[XB_TOPGEN]) == tg, bar);
            __builtin_amdgcn_fence(__ATOMIC_ACQUIRE, "agent");
            xb_add(&bar[XB_XGEN(b.x)], 1u);
            asm volatile("s_waitcnt vmcnt(0)" ::: "memory");
        } else {
            XB_SPIN(xb_ld(&bar[XB_XGEN(b.x)]) == gen, bar);
            __builtin_amdgcn_fence(__ATOMIC_ACQUIRE, "agent");
            asm volatile("s_waitcnt vmcnt(0)" ::: "memory");
        }
    }
    __syncthreads();
}

namespace att {
typedef float f32x16 __attribute__((ext_vector_type(16)));
typedef short s16x4 __attribute__((ext_vector_type(4)));
constexpr float SB_DONE = 281474976710656.0f;
constexpr int SHM_K = 64 * 128 * 2, SHM_V = 64 * 128 * 2, SHM_P = 64 * 64 * 2;
#define KSWZ(row, colB) ((row) * 256 + ((colB) ^ (((row) & 7) << 4)))
#define PSWZ(row, colB) ((row) * 128 + ((colB) ^ ((((row) >> 1) & 7) << 4)))
#define SBAR() __builtin_amdgcn_sched_barrier(0)
__device__ __forceinline__ int v_st(int k, int c) { const int kk = (k & ~0xC) | ((k & 4) << 1) | ((k & 8) >> 1); return ((kk >> 3) * 4 + (c >> 5)) * 512 + ((kk & 7) * 32 + (c & 31)) * 2; }
__device__ __forceinline__ int v_rd_base(int lane) { return ((lane & 3) << 3) | (((lane >> 2) & 3) << 6) | (((lane >> 4) & 1) << 5) | (((lane >> 5) & 1) << 8); }
__device__ __forceinline__ unsigned cvtpk(float lo, float hi) { unsigned r; asm volatile("v_cvt_pk_bf16_f32 %0, %1, %2" : "=v"(r) : "v"(lo), "v"(hi)); return r; }
#define PK4(P, B_, OUT) do { unsigned a0 = cvtpk(P[B_+0], P[B_+1]), a1 = cvtpk(P[B_+2], P[B_+3]), b0 = cvtpk(P[B_+4], P[B_+5]), b1 = cvtpk(P[B_+6], P[B_+7]); \
        auto r0 = __builtin_amdgcn_permlane32_swap(a0, b0, false, false); auto r1 = __builtin_amdgcn_permlane32_swap(a1, b1, false, false); \
        v4u w = {r0[0], r1[0], r0[1], r1[1]}; OUT = __builtin_bit_cast(bf16x8, w); } while (0)
__device__ __forceinline__ void qkt128(f32x16& p0, f32x16& p1, const LAS unsigned char* Kt, int r32, int hi, const bf16x8* qr) {
    const LAS unsigned char* kb[4];
#pragma unroll
    for (int dd = 0; dd < 4; ++dd) kb[dd] = Kt + KSWZ(r32, (dd * 16 + hi * 8) * 2);
#pragma unroll
    for (int d0 = 0; d0 < 8; ++d0) { const LAS unsigned char* a = kb[d0 & 3] + (d0 >> 2) * 128;
        const bf16x8 b0 = *(const LAS bf16x8*)a, b1 = *(const LAS bf16x8*)(a + 32 * 256);
        p0 = __builtin_amdgcn_mfma_f32_32x32x16_bf16(b0, qr[d0], p0, 0, 0, 0);
        p1 = __builtin_amdgcn_mfma_f32_32x32x16_bf16(b1, qr[d0], p1, 0, 0, 0); }
}
__device__ __forceinline__ void pv_tile(f32x16* o, int vb, bf16x8 pa0, bf16x8 pa1, bf16x8 pa2, bf16x8 pa3) {
#define TRRD(dst, off) asm volatile("ds_read_b64_tr_b16 %0, %1 offset:%2" : "=&v"(dst) : "v"(vb), "i"(off) : "memory")
#define PV_RD(S, d0) do { constexpr int b_ = (d0) * 512; TRRD(S##l0, b_); TRRD(S##h0, b_ + 2048); TRRD(S##l1, b_ + 4096); TRRD(S##h1, b_ + 6144); TRRD(S##l2, b_ + 8192); TRRD(S##h2, b_ + 10240); TRRD(S##l3, b_ + 12288); TRRD(S##h3, b_ + 14336); } while (0)
#define PV_MM(S, d0) do { \
        o[d0] = __builtin_amdgcn_mfma_f32_32x32x16_bf16((bf16x8){S##l0[0], S##l0[1], S##l0[2], S##l0[3], S##h0[0], S##h0[1], S##h0[2], S##h0[3]}, pa0, o[d0], 0, 0, 0); \
        o[d0] = __builtin_amdgcn_mfma_f32_32x32x16_bf16((bf16x8){S##l1[0], S##l1[1], S##l1[2], S##l1[3], S##h1[0], S##h1[1], S##h1[2], S##h1[3]}, pa1, o[d0], 0, 0, 0); \
        o[d0] = __builtin_amdgcn_mfma_f32_32x32x16_bf16((bf16x8){S##l2[0], S##l2[1], S##l2[2], S##l2[3], S##h2[0], S##h2[1], S##h2[2], S##h2[3]}, pa2, o[d0], 0, 0, 0); \
        o[d0] = __builtin_amdgcn_mfma_f32_32x32x16_bf16((bf16x8){S##l3[0], S##l3[1], S##l3[2], S##l3[3], S##h3[0], S##h3[1], S##h3[2], S##h3[3]}, pa3, o[d0], 0, 0, 0); } while (0)
    s16x4 Al0, Al1, Al2, Al3, Ah0, Ah1, Ah2, Ah3, Bl0, Bl1, Bl2, Bl3, Bh0, Bh1, Bh2, Bh3;
    PV_RD(A, 0); PV_RD(B, 1);
    asm volatile("s_waitcnt lgkmcnt(8)" ::: "memory"); SBAR(); PV_MM(A, 0); SBAR();
    PV_RD(A, 2);
    asm volatile("s_waitcnt lgkmcnt(8)" ::: "memory"); SBAR(); PV_MM(B, 1); SBAR();
    PV_RD(B, 3);
    asm volatile("s_waitcnt lgkmcnt(8)" ::: "memory"); SBAR(); PV_MM(A, 2); SBAR();
    asm volatile("s_waitcnt lgkmcnt(0)" ::: "memory"); SBAR(); PV_MM(B, 3);
#undef PV_RD
#undef PV_MM
#undef TRRD
}
typedef __bf16 bf16x2_t __attribute__((ext_vector_type(2)));
__device__ __forceinline__ unsigned cvtpk_c(float a, float b) { const f32x2 f = {a, b}; return __builtin_bit_cast(unsigned, __builtin_convertvector(f, bf16x2_t)); }
__device__ __forceinline__ void store_o(const f32x16* o, bf16* Ow  , int r32, int hi, float scale) {
    bf16* row = Ow + (size_t)r32 * 2048 + hi * 8;
#pragma unroll
    for (int d0 = 0; d0 < 4; ++d0) {
#pragma unroll
        for (int b8 = 0; b8 < 16; b8 += 8) {
            const unsigned a0 = cvtpk_c(o[d0][b8 + 0] * scale, o[d0][b8 + 1] * scale), a1 = cvtpk_c(o[d0][b8 + 2] * scale, o[d0][b8 + 3] * scale);
            const unsigned b0 = cvtpk_c(o[d0][b8 + 4] * scale, o[d0][b8 + 5] * scale), b1 = cvtpk_c(o[d0][b8 + 6] * scale, o[d0][b8 + 7] * scale);
            auto r0 = __builtin_amdgcn_permlane32_swap(a0, b0, false, false); auto r1 = __builtin_amdgcn_permlane32_swap(a1, b1, false, false);
            *(v4u*)(row + d0 * 32 + 2 * b8) = (v4u){r0[0], r1[0], r0[1], r1[1]}; } }
}

__device__ __forceinline__ void sb_unit(const bf16* __restrict__ qkv, bf16* __restrict__ ob, int b, int h, int qb, LAS unsigned char* lds) {
    int tid_ = threadIdx.x; asm volatile("" : "+v"(tid_));
    const int tid = tid_, wid = __builtin_amdgcn_readfirstlane(tid >> 6), lane = tid & 63, r32 = lane & 31, hi = lane >> 5;
    const size_t rowbase = (size_t)b * SEQ; const int q0 = qb * 256;
    const bf16* Kg = qkv + rowbase * 6144 + 2048 + h * 128; const bf16* Vg = qkv + rowbase * 6144 + 4096 + h * 128;
    LAS unsigned char* V_lds = lds; LAS unsigned char* K_lds = lds + 2 * SHM_V;
    const int sr = tid >> 4, sc = (tid & 15) * 8, vst0 = v_st(sr, sc), vst1 = v_st(32 + sr, sc), kws = KSWZ(sr, sc * 2);
    const int vb0 = (int)(unsigned)(uintptr_t)V_lds + v_rd_base(lane);
    bf16x8 qr[8];
    { const bf16* Qw = qkv + (rowbase + q0 + wid * 32 + r32) * 6144 + h * 128;
#pragma unroll
      for (int d0 = 0; d0 < 8; ++d0) qr[d0] = *(const bf16x8*)(Qw + d0 * 16 + hi * 8); }
    const int NT = 4 * qb + 4;
    const int jmax = 4 * qb + (wid >> 1);
    const int qrow = q0 + wid * 32 + r32;
    f32x16 o[4]; o[0] = f32x16{}; o[1] = f32x16{}; o[2] = f32x16{}; o[3] = f32x16{};
    float run = 1.0f;
    bf16x8 st_k0, st_k1, st_v0, st_v1;
#define SLOAD(jt) do { const size_t k0_ = (size_t)(jt) * 64; st_v0 = *(const bf16x8*)(Vg + (k0_ + sr) * 6144 + sc); st_v1 = *(const bf16x8*)(Vg + (k0_ + 32 + sr) * 6144 + sc); \
                       st_k0 = *(const bf16x8*)(Kg + (k0_ + sr) * 6144 + sc); st_k1 = *(const bf16x8*)(Kg + (k0_ + 32 + sr) * 6144 + sc); } while (0)
#define SWRITE(bf) do { *(LAS bf16x8*)(V_lds + (bf) * SHM_V + vst0) = st_v0; *(LAS bf16x8*)(V_lds + (bf) * SHM_V + vst1) = st_v1; \
                        *(LAS bf16x8*)(K_lds + (bf) * SHM_K + kws) = st_k0; *(LAS bf16x8*)(K_lds + (bf) * SHM_K + kws + 32 * 256) = st_k1; } while (0)
    SLOAD(NT - 1); VM_WAIT(); SWRITE(0); if (NT > 1) SLOAD(NT - 2);
    __syncthreads();
    bool wdone = false;
    for (int i = 0; i < NT; ++i) {
        const int jt = NT - 1 - i, bf = i & 1;
        if (jt <= jmax && !wdone) {
            f32x16 p0 = f32x16{}, p1 = f32x16{}, u0, u1;
            qkt128(p0, p1, K_lds + bf * SHM_K, r32, hi, qr);
            const int dq = qrow - jt * 64 - 4 * hi;
            const bool need_mask = (jt * 64 + 63 >= q0 + wid * 32);
#define SB_EU(MASKED) do { _Pragma("unroll") for (int r = 0; r < 16; ++r) { const int c = (r & 3) + 8 * (r >> 2); \
                { float E = __builtin_amdgcn_exp2f(fminf(p0[r], 64.f)); float u = 1.0f + E; if (MASKED && !(c < dq)) { E = 0.f; u = 1.0f; } p0[r] = E; u0[r] = u; } \
                { float E = __builtin_amdgcn_exp2f(fminf(p1[r], 64.f)); float u = 1.0f + E; if (MASKED && !(c + 32 < dq)) { E = 0.f; u = 1.0f; } p1[r] = E; u1[r] = u; } } } while (0)
            if (need_mask) SB_EU(true); else SB_EU(false);
#undef SB_EU
            float Ip[9], oth[9];
#pragma unroll
            for (int j = 0; j < 4; ++j) { u0[4 * j + 2] *= u0[4 * j + 3]; u0[4 * j + 1] *= u0[4 * j + 2]; u0[4 * j] *= u0[4 * j + 1];
                                          u1[4 * j + 2] *= u1[4 * j + 3]; u1[4 * j + 1] *= u1[4 * j + 2]; u1[4 * j] *= u1[4 * j + 1]; }
            Ip[8] = 1.0f; Ip[7] = u1[12];
#pragma unroll
            for (int j = 6; j >= 0; --j) Ip[j] = Ip[j + 1] * ((j < 4) ? u0[4 * j] : u1[4 * (j - 4)]);
#pragma unroll
            for (int j = 0; j < 8; ++j) { auto rr = __builtin_amdgcn_permlane32_swap(__float_as_uint(Ip[j]), __float_as_uint(Ip[j + 1]), false, false); oth[j] = __uint_as_float(hi ? rr[0] : rr[1]); }
            { auto rr = __builtin_amdgcn_permlane32_swap(__float_as_uint(Ip[0]), __float_as_uint(Ip[0]), false, false); oth[8] = __uint_as_float(hi ? rr[0] : rr[1]); }
#pragma unroll
            for (int j = 0; j < 8; ++j) {
                const float T = (Ip[j + 1] * oth[j]) * run;
#pragma unroll
                for (int e = 0; e < 4; ++e) {
                    if (j < 4) p0[4 * j + e] *= __builtin_amdgcn_rcpf(u0[4 * j + e] * T);
                    else       p1[4 * (j - 4) + e] *= __builtin_amdgcn_rcpf(u1[4 * (j - 4) + e] * T); }
            }
            run *= Ip[0] * oth[8];
            bf16x8 pa0, pa1, pa2, pa3;
            PK4(p0, 0, pa0); PK4(p0, 8, pa1); PK4(p1, 0, pa2); PK4(p1, 8, pa3);
            SBAR();
            pv_tile(o, vb0 + bf * SHM_V, pa0, pa1, pa2, pa3);
        }
        if (i + 1 < NT) { VM_WAIT(); SWRITE((i + 1) & 1); if (i + 2 < NT) SLOAD(NT - 3 - i); }
        { LAS unsigned* fl = (LAS unsigned*)(lds + 2 * SHM_V + 2 * SHM_K) + (i & 1) * 8;
          wdone = __all(run >= SB_DONE);
          if (lane == 0) fl[wid] = wdone ? 1u : 0u;
          __syncthreads();
          const v4u f0 = *(const LAS v4u*)fl, f1 = *(const LAS v4u*)(fl + 4);
          if ((f0.x & f0.y & f0.z & f0.w & f1.x & f1.y & f1.z & f1.w) != 0u) break; }
    }
#undef SLOAD
#undef SWRITE
    store_o(o, ob + (rowbase + q0 + wid * 32) * 2048 + h * 128, r32, hi, 1.0f);
}
__device__ __forceinline__ void sb_phase(const bf16* qkv, bf16* ob, LAS unsigned char* lds, int vcu, int G) {
    for (int item = vcu; item < BATCH * NH * 16; item += G) {
        const int bh = item >> 4, x = item & 15;
        sb_unit(qkv, ob, bh / NH, bh % NH, 31 - x, lds);
        sb_unit(qkv, ob, bh / NH, bh % NH, x, lds);
    }
}

__device__ __forceinline__ void mla_unit(const bf16* __restrict__ qm, const bf16* __restrict__ kvm, const bf16* __restrict__ kpe, bf16* __restrict__ ob, int b, int h, int qb, LAS unsigned char* lds) {
    int tid_ = threadIdx.x; asm volatile("" : "+v"(tid_));
    const int tid = tid_, wid = __builtin_amdgcn_readfirstlane(tid >> 6), lane = tid & 63, r32 = lane & 31, hi = lane >> 5;
    const size_t rowbase = (size_t)b * SEQ; const int q0 = qb * 256;
    const bf16* Kg = kvm + rowbase * 4096 + h * 256; const bf16* Vg = Kg + 128; const bf16* Pg = kpe + rowbase * 64;
    LAS unsigned char* V_lds = lds; LAS unsigned char* K_lds = lds + 2 * SHM_V; LAS unsigned char* P_lds = lds + 2 * SHM_V + 2 * SHM_K;
    (void)0;
    const int sr = tid >> 4, sc = (tid & 15) * 8, vst0 = v_st(sr, sc), vst1 = v_st(32 + sr, sc), kws = KSWZ(sr, sc * 2);
    const int pr = tid >> 3, pc = (tid & 7) * 8, pws = PSWZ(pr, pc * 2);
    const int vb0 = (int)(unsigned)(uintptr_t)V_lds + v_rd_base(lane);
    bf16x8 qr[12];
    { const bf16* Qw = qm + (rowbase + q0 + wid * 32 + r32) * 3072 + h * 192;
#pragma unroll
      for (int d0 = 0; d0 < 12; ++d0) qr[d0] = *(const bf16x8*)(Qw + d0 * 16 + hi * 8); }
    const int NT = 4 * qb + 4, jmax = 4 * qb + (wid >> 1);
    f32x16 o[4]; o[0] = f32x16{}; o[1] = f32x16{}; o[2] = f32x16{}; o[3] = f32x16{};
    float m_reg = -1e30f, l_reg = 0.f;
    bf16x8 sa_k0, sa_k1, sa_v0, sa_v1, sa_p, sb_k0, sb_k1, sb_v0, sb_v1, sb_p;
#define SLOAD(S, jt) do { const size_t k0_ = (size_t)(jt) * 64; S##_v0 = *(const bf16x8*)(Vg + (k0_ + sr) * 4096 + sc); S##_v1 = *(const bf16x8*)(Vg + (k0_ + 32 + sr) * 4096 + sc); \
                          S##_k0 = *(const bf16x8*)(Kg + (k0_ + sr) * 4096 + sc); S##_k1 = *(const bf16x8*)(Kg + (k0_ + 32 + sr) * 4096 + sc); S##_p = *(const bf16x8*)(Pg + (k0_ + pr) * 64 + pc); } while (0)
#define SWRITE(S, bf) do { *(LAS bf16x8*)(V_lds + (bf) * SHM_V + vst0) = S##_v0; *(LAS bf16x8*)(V_lds + (bf) * SHM_V + vst1) = S##_v1; \
                           *(LAS bf16x8*)(K_lds + (bf) * SHM_K + kws) = S##_k0; *(LAS bf16x8*)(K_lds + (bf) * SHM_K + kws + 32 * 256) = S##_k1; *(LAS bf16x8*)(P_lds + (bf) * SHM_P + pws) = S##_p; } while (0)
    SLOAD(sa, 0); SLOAD(sb, 1); SWRITE(sa, 0); SLOAD(sa, 2);
    __syncthreads();
    auto tile = [&](const int jt, const int bf) __attribute__((always_inline)) {
        if (jt <= jmax) {
            f32x16 p0 = f32x16{}, p1 = f32x16{};
            qkt128(p0, p1, K_lds + bf * SHM_K, r32, hi, qr);
            { const LAS unsigned char* Pt = P_lds + bf * SHM_P;
#pragma unroll
              for (int dd = 0; dd < 4; ++dd) { const LAS unsigned char* a = Pt + PSWZ(r32, (dd * 16 + hi * 8) * 2);
                  const bf16x8 b0 = *(const LAS bf16x8*)a, b1 = *(const LAS bf16x8*)(a + 32 * 128);
                  p0 = __builtin_amdgcn_mfma_f32_32x32x16_bf16(b0, qr[8 + dd], p0, 0, 0, 0);
                  p1 = __builtin_amdgcn_mfma_f32_32x32x16_bf16(b1, qr[8 + dd], p1, 0, 0, 0); } }
            float pmax = p0[0];
#pragma unroll
            for (int r = 1; r < 16; ++r) pmax = fmaxf(pmax, p0[r]);
#pragma unroll
            for (int r = 0; r < 16; ++r) pmax = fmaxf(pmax, p1[r]);
            { auto rr = __builtin_amdgcn_permlane32_swap(__float_as_uint(pmax), __float_as_uint(pmax), false, false); pmax = fmaxf(__uint_as_float(rr[0]), __uint_as_float(rr[1])); }
            const float mn = fmaxf(m_reg, pmax); const float alpha = __builtin_amdgcn_exp2f(m_reg - mn); m_reg = mn;
            float ps = 0.f;
#pragma unroll
            for (int r = 0; r < 16; ++r) { p0[r] = __builtin_amdgcn_exp2f(p0[r] - mn); p1[r] = __builtin_amdgcn_exp2f(p1[r] - mn); ps += p0[r] + p1[r]; }
            { auto rr = __builtin_amdgcn_permlane32_swap(__float_as_uint(ps), __float_as_uint(ps), false, false); ps = __uint_as_float(rr[0]) + __uint_as_float(rr[1]); }
            l_reg = l_reg * alpha + ps;
            if (__any(alpha < 1.f)) {
#pragma unroll
                for (int d0 = 0; d0 < 4; ++d0) o[d0] = o[d0] * alpha;
            }
            bf16x8 pa0, pa1, pa2, pa3;
            PK4(p0, 0, pa0); PK4(p0, 8, pa1); PK4(p1, 0, pa2); PK4(p1, 8, pa3);
            SBAR();
            pv_tile(o, vb0 + bf * SHM_V, pa0, pa1, pa2, pa3);
        }
    };
    for (int jt = 0; jt < NT; jt += 2) {
        tile(jt, 0);
        SWRITE(sb, 1); if (jt + 3 < NT) SLOAD(sb, jt + 3);
        __syncthreads();
        tile(jt + 1, 1);
        if (jt + 2 < NT) { SWRITE(sa, 0); if (jt + 4 < NT) SLOAD(sa, jt + 4); }
        __syncthreads();
    }
#undef SLOAD
#undef SWRITE
    store_o(o, ob + (rowbase + q0 + wid * 32) * 2048 + h * 128, r32, hi, 1.0f / l_reg);
}
__device__ __forceinline__ void mla_phase(const bf16* qm, const bf16* kvm, const bf16* kpe, bf16* ob, LAS unsigned char* lds, int vcu, int G) {
    for (int item = vcu; item < BATCH * NH * 16; item += G) {
        const int bh = item >> 4, x = item & 15;
        mla_unit(qm, kvm, kpe, ob, bh / NH, bh % NH, 31 - x, lds);
        mla_unit(qm, kvm, kpe, ob, bh / NH, bh % NH, x, lds);
    }
}
#undef KSWZ
#undef PSWZ
#undef SBAR
#undef PK4
}

namespace hg {
using att::f32x16; using att::s16x4;
#define KSWZ(row, colB) ((row) * 256 + ((colB) ^ (((row) & 7) << 4)))
#define TRRD(dst, base, off) asm volatile("ds_read_b64_tr_b16 %0, %1 offset:%2" : "=&v"(dst) : "v"(base), "i"(off) : "memory")
#define FRAG(dst, base, ks) do { s16x4 lo_, hi_; TRRD(lo_, base, (ks) * 4096); TRRD(hi_, base, (ks) * 4096 + 2048); asm volatile("s_waitcnt lgkmcnt(0)" ::: "memory"); __builtin_amdgcn_sched_barrier(0);   \
        dst = (bf16x8){lo_[0], lo_[1], lo_[2], lo_[3], hi_[0], hi_[1], hi_[2], hi_[3]}; } while (0)
typedef __bf16 bf16x2_t __attribute__((ext_vector_type(2)));
__device__ __forceinline__ unsigned cvtpk_c(float a, float b) { const f32x2 f = {a, b}; return __builtin_bit_cast(unsigned, __builtin_convertvector(f, bf16x2_t)); }
__device__ __forceinline__ int crow(int r, int hi) { return (r & 3) + 8 * (r >> 2) + 4 * hi; }
__device__ __forceinline__ void st_bf16(LAS unsigned char* p, float v) { *(LAS unsigned short*)p = (unsigned short)f2bf(v); }

__device__ __forceinline__ void pass_a(const bf16* __restrict__ ib, const float* __restrict__ lf, bf16* __restrict__ kvs, float* __restrict__ dec, LAS unsigned char* lds, int vcu, int G) {
    int tid_ = threadIdx.x; asm volatile("" : "+v"(tid_));
    const int tid = tid_, wid = __builtin_amdgcn_readfirstlane(tid >> 6), lane = tid & 63, r32 = lane & 31, hi = lane >> 5;
    LAS unsigned char* Kh = lds; LAS unsigned char* Vt = lds + 16384; LAS float* tot = (LAS float*)(lds + 32768);
    const int sr = tid >> 4, sc = (tid & 15) * 8;
    const int c4 = (tid & 31) * 4, rg = tid >> 5, rg0 = 2 * wid;
    const int vblk = wid >> 1, cblk0 = 2 * (wid & 1);
    const int vbV = (int)(unsigned)(uintptr_t)Vt + att::v_rd_base(lane) + vblk * 512, vbK = (int)(unsigned)(uintptr_t)Kh + att::v_rd_base(lane) + cblk0 * 512;
    bf16x8 st_v0, st_v1; f32x4 lw[4];
#define A_LOAD(U) do { const int bh_ = (U) >> 7, n_ = (U) & 127; const size_t r0_ = (size_t)(bh_ >> 4) * SEQ + (size_t)n_ * 64; const int h_ = bh_ & 15; \
        st_v0 = *(const bf16x8*)(ib + (r0_ + sr) * 2048 + h_ * 128 + sc); st_v1 = *(const bf16x8*)(ib + (r0_ + 32 + sr) * 2048 + h_ * 128 + sc); \
        _Pragma("unroll") for (int j = 0; j < 4; ++j) lw[j] = *(const f32x4*)(lf + (r0_ + 4 * rg + j) * 2048 + h_ * 128 + c4); } while (0)
    if (vcu < BATCH * NH * NCHUNK) A_LOAD(vcu);
    for (int unit = vcu; unit < BATCH * NH * NCHUNK; unit += G) {
        f32x4 bb[4];
        bb[0] = lw[0]; bb[1] = bb[0] + lw[1]; bb[2] = bb[1] + lw[2]; bb[3] = bb[2] + lw[3];
        *(LAS f32x4*)(tot + rg * 128 + c4) = bb[3];
        *(LAS bf16x8*)(Vt + att::v_st(sr, sc)) = st_v0; *(LAS bf16x8*)(Vt + att::v_st(32 + sr, sc)) = st_v1;
        __syncthreads();
        f32x4 offs = (f32x4){0.f, 0.f, 0.f, 0.f};
        for (int g = 0; g < rg0; ++g) offs = offs + *(const LAS f32x4*)(tot + g * 128 + c4);
        f32x4 blast = offs;
        { const f32x4 own0 = *(const LAS f32x4*)(tot + rg0 * 128 + c4); blast = blast + own0; if (rg != rg0) offs = offs + own0; }
        for (int g = rg0 + 1; g < 16; ++g) blast = blast + *(const LAS f32x4*)(tot + g * 128 + c4);
#pragma unroll
        for (int j = 0; j < 4; ++j) { const f32x4 bf = bb[j] + offs; float kh[4];
#pragma unroll
            for (int e = 0; e < 4; ++e) kh[e] = (1.0f - __expf(lw[j][e])) * __expf(blast[e] - bf[e]);
            v2u w; w.x = pk2(kh[0], kh[1]); w.y = pk2(kh[2], kh[3]);
            *(LAS v2u*)(Kh + att::v_st(4 * rg + j, c4)) = w; }
        if (unit + G < BATCH * NH * NCHUNK) A_LOAD(unit + G);
        if (rg == 0) { f32x4 d4; d4[0] = __expf(blast[0]); d4[1] = __expf(blast[1]); d4[2] = __expf(blast[2]); d4[3] = __expf(blast[3]); *(f32x4*)(dec + (size_t)unit * 128 + c4) = d4; }
        __syncthreads();
        f32x16 a0 = f32x16{}, a1 = f32x16{};
#pragma unroll
        for (int ks = 0; ks < 4; ++ks) { bf16x8 fa, fb0, fb1; FRAG(fa, vbV, ks); FRAG(fb0, vbK, ks); { const int vbK1 = vbK + 512; FRAG(fb1, vbK1, ks); }
            a0 = __builtin_amdgcn_mfma_f32_32x32x16_bf16(fb0, fa, a0, 0, 0, 0); a1 = __builtin_amdgcn_mfma_f32_32x32x16_bf16(fb1, fa, a1, 0, 0, 0); }
        bf16* dst = kvs + (size_t)unit * 16384 + (size_t)(vblk * 32 + r32) * 128 + cblk0 * 32 + hi * 8;
#define A_PK4(P, B_, OUT) do { unsigned a0_ = cvtpk_c(P[B_+0], P[B_+1]), a1_ = cvtpk_c(P[B_+2], P[B_+3]), b0_ = cvtpk_c(P[B_+4], P[B_+5]), b1_ = cvtpk_c(P[B_+6], P[B_+7]); \
        auto r0_ = __builtin_amdgcn_permlane32_swap(a0_, b0_, false, false); auto r1_ = __builtin_amdgcn_permlane32_swap(a1_, b1_, false, false); \
        OUT = (v4u){r0_[0], r1_[0], r0_[1], r1_[1]}; } while (0)
        { v4u w0, w1, w2, w3; A_PK4(a0, 0, w0); A_PK4(a0, 8, w1); A_PK4(a1, 0, w2); A_PK4(a1, 8, w3);
          *(v4u*)(dst) = w0; *(v4u*)(dst + 16) = w1; *(v4u*)(dst + 32) = w2; *(v4u*)(dst + 48) = w3; }
#undef A_PK4
        __syncthreads();
    }
#undef A_LOAD
}
__device__ __forceinline__ void pass_b(bf16* __restrict__ kvs, const float* __restrict__ dec, LAS unsigned char* lds, int vcu, int G) {
    int tid_ = threadIdx.x; asm volatile("" : "+v"(tid_));
    LAS float* dl = (LAS float*)lds;
    for (int idx = vcu * 512 + tid_; idx < BATCH * NH * 8192; idx += G * 512) {
        const int bh = idx >> 13, rem = idx & 8191, v = rem >> 6, cp = rem & 63;
        unsigned* p = (unsigned*)(kvs + (size_t)bh * 128 * 16384 + v * 128 + 2 * cp);
        __syncthreads();
        { const float* dsrc = dec + (size_t)bh * 128 * 128;
#pragma unroll
          for (int j = 0; j < 8; ++j) *(LAS f32x4*)(dl + (tid_ + 512 * j) * 4) = *(const f32x4*)(dsrc + (tid_ + 512 * j) * 4); }
        __syncthreads();
        const LAS float* dq = dl + 2 * cp;
        float S0 = 0.f, S1 = 0.f;
        unsigned la[32], lb[32];
#define B_LOAD(L, N0) do { _Pragma("unroll") for (int k = 0; k < 32; ++k) L[k] = p[(size_t)((N0) + k) * 8192]; } while (0)
#define B_STEP(L, N0) do { _Pragma("unroll") for (int k = 0; k < 32; ++k) { const f32x2 dd = *(const LAS f32x2*)(dq + ((N0) + k) * 128); p[(size_t)((N0) + k) * 8192] = pk2(S0, S1); \
                S0 = dd.x * S0 + __builtin_bit_cast(float, L[k] << 16); S1 = dd.y * S1 + __builtin_bit_cast(float, L[k] & 0xffff0000u); } } while (0)
        B_LOAD(la, 0);
        for (int n0 = 0; n0 < NCHUNK; n0 += 64) {
            B_LOAD(lb, n0 + 32);
            B_STEP(la, n0);
            if (n0 + 64 < NCHUNK) B_LOAD(la, n0 + 64);
            B_STEP(lb, n0 + 32);
        }
#undef B_LOAD
#undef B_STEP
    }
}
__device__ __forceinline__ void pass_c(const bf16* __restrict__ qb, const bf16* __restrict__ ib, const bf16* __restrict__ gb, const float* __restrict__ lf, const bf16* __restrict__ kvs,
                                       const float* __restrict__ gnorm, bf16* __restrict__ ob, LAS unsigned char* lds, int vcu, int G) {
    int tid_ = threadIdx.x; asm volatile("" : "+v"(tid_));
    const int tid = tid_, wid = __builtin_amdgcn_readfirstlane(tid >> 6), lane = tid & 63, r32 = lane & 31, hi = lane >> 5;
    LAS unsigned char* Kt = lds; LAS unsigned char* Vt = lds + 16384; LAS unsigned char* Qt = lds + 32768; LAS unsigned char* Qi = lds + 49152;
    LAS float* tot = (LAS float*)(lds + 65536); LAS float* sst = (LAS float*)(lds + 73728);
    const int sr = tid >> 4, sc = (tid & 15) * 8;
    const int c4 = (tid & 31) * 4, rg = tid >> 5, rg0 = 2 * wid;
    const int tb = wid & 1, vblk = wid >> 1;
    const int vbV = (int)(unsigned)(uintptr_t)Vt + att::v_rd_base(lane) + vblk * 512;
    bf16x8 st_v0, st_v1; v2u g0[4], ng0[4]; f32x4 lw[4]; v2u qw[4];
    f32x4 gn[4];
#pragma unroll
    for (int g = 0; g < 4; ++g) gn[g] = *(const f32x4*)(gnorm + 32 * vblk + 8 * g + 4 * hi);
#define C_LOAD(U, G0) do { const int bh_ = (U) >> 7, n_ = (U) & 127; const size_t r0_ = (size_t)(bh_ >> 4) * SEQ + (size_t)n_ * 64; const int h_ = bh_ & 15; \
        st_v0 = *(const bf16x8*)(ib + (r0_ + sr) * 2048 + h_ * 128 + sc); st_v1 = *(const bf16x8*)(ib + (r0_ + 32 + sr) * 2048 + h_ * 128 + sc); \
        _Pragma("unroll") for (int j = 0; j < 4; ++j) { const size_t e_ = (r0_ + 4 * rg + j) * 2048 + h_ * 128 + c4; lw[j] = *(const f32x4*)(lf + e_); qw[j] = *(const v2u*)(qb + e_); } \
        { const size_t e_ = (r0_ + tb * 32 + r32) * 2048 + h_ * 128 + 32 * vblk + 4 * hi; _Pragma("unroll") for (int g = 0; g < 4; ++g) G0[g] = *(const v2u*)(gb + e_ + 8 * g); } } while (0)
    if (vcu < BATCH * NH * NCHUNK) C_LOAD(vcu, g0);
    for (int unit = vcu; unit < BATCH * NH * NCHUNK; unit += G) {
        const int bh = unit >> 7, n = unit & 127, b = bh >> 4, h = bh & 15; const size_t r0 = (size_t)b * SEQ + (size_t)n * 64;
        bf16x8 sf[8];
        { const bf16* Sg = kvs + (size_t)unit * 16384 + (size_t)(vblk * 32 + r32) * 128 + hi * 8;
#pragma unroll
          for (int d0 = 0; d0 < 8; ++d0) sf[d0] = *(const bf16x8*)(Sg + d0 * 16); }
        f32x4 bb[4];
        bb[0] = lw[0]; bb[1] = bb[0] + lw[1]; bb[2] = bb[1] + lw[2]; bb[3] = bb[2] + lw[3];
        *(LAS f32x4*)(tot + rg * 128 + c4) = bb[3];
        *(LAS bf16x8*)(Vt + att::v_st(sr, sc)) = st_v0; *(LAS bf16x8*)(Vt + att::v_st(32 + sr, sc)) = st_v1;
        __syncthreads();
        f32x4 offs, bm;
        { f32x4 S = (f32x4){0.f, 0.f, 0.f, 0.f}; const int gm = rg0 < 8 ? rg0 : 8;
          for (int g = 0; g < gm; ++g) S = S + *(const LAS f32x4*)(tot + g * 128 + c4);
          if (rg0 <= 8) { offs = S; f32x4 T = S; for (int g = rg0; g < 8; ++g) T = T + *(const LAS f32x4*)(tot + g * 128 + c4); bm = T; }
          else { bm = S; for (int g = 8; g < rg0; ++g) S = S + *(const LAS f32x4*)(tot + g * 128 + c4); offs = S; }
          if (rg != rg0) offs = offs + *(const LAS f32x4*)(tot + rg0 * 128 + c4); }
#pragma unroll
        for (int j = 0; j < 4; ++j) { const int row = 4 * rg + j; const f32x4 bf = bb[j] + offs; float kt[4], qt[4], qi[4];
            const float q4[4] = {__builtin_bit_cast(float, qw[j].x << 16), __builtin_bit_cast(float, qw[j].x & 0xffff0000u), __builtin_bit_cast(float, qw[j].y << 16), __builtin_bit_cast(float, qw[j].y & 0xffff0000u)};
#pragma unroll
            for (int e = 0; e < 4; ++e) { const float dm = bf[e] - bm[e];
                qi[e] = q4[e] * __expf(bf[e]); qt[e] = q4[e] * __expf(fminf(dm, 80.f)); kt[e] = (1.0f - __expf(lw[j][e])) * __expf(fminf(-dm, 80.f)); }
            const int off = KSWZ(row, c4 * 2);
            { v2u w; w.x = pk2(kt[0], kt[1]); w.y = pk2(kt[2], kt[3]); *(LAS v2u*)(Kt + off) = w; }
            { v2u w; w.x = pk2(qt[0], qt[1]); w.y = pk2(qt[2], qt[3]); *(LAS v2u*)(Qt + off) = w; }
            { v2u w; w.x = pk2(qi[0], qi[1]); w.y = pk2(qi[2], qi[3]); *(LAS v2u*)(Qi + off) = w; } }
        if (unit + G < BATCH * NH * NCHUNK) C_LOAD(unit + G, ng0);
        __syncthreads();
        bf16x8 qr[8];
#pragma unroll
        for (int d0 = 0; d0 < 8; ++d0) qr[d0] = *(const LAS bf16x8*)(Qt + KSWZ(tb * 32 + r32, (d0 * 16 + hi * 8) * 2));
        f32x16 p0 = f32x16{}, p1 = f32x16{};
        att::qkt128(p0, p1, Kt, r32, hi, qr);
        const int t = tb * 32 + r32;
#pragma unroll
        for (int r = 0; r < 16; ++r) { const int s = crow(r, hi); if (!(s <= t)) p0[r] = 0.f; if (!(s + 32 <= t)) p1[r] = 0.f; }
        bf16x8 pa0, pa1, pa2, pa3;
#define PK4(P, B_, OUT) do { unsigned a0_ = att::cvtpk(P[B_+0], P[B_+1]), a1_ = att::cvtpk(P[B_+2], P[B_+3]), b0_ = att::cvtpk(P[B_+4], P[B_+5]), b1_ = att::cvtpk(P[B_+6], P[B_+7]); \
        auto r0_ = __builtin_amdgcn_permlane32_swap(a0_, b0_, false, false); auto r1_ = __builtin_amdgcn_permlane32_swap(a1_, b1_, false, false); \
        v4u w_ = {r0_[0], r1_[0], r0_[1], r1_[1]}; OUT = __builtin_bit_cast(bf16x8, w_); } while (0)
        PK4(p0, 0, pa0); PK4(p0, 8, pa1); PK4(p1, 0, pa2); PK4(p1, 8, pa3);
#undef PK4
        f32x16 o = f32x16{};
        { bf16x8 fv; FRAG(fv, vbV, 0); o = __builtin_amdgcn_mfma_f32_32x32x16_bf16(fv, pa0, o, 0, 0, 0); FRAG(fv, vbV, 1); o = __builtin_amdgcn_mfma_f32_32x32x16_bf16(fv, pa1, o, 0, 0, 0);
          FRAG(fv, vbV, 2); o = __builtin_amdgcn_mfma_f32_32x32x16_bf16(fv, pa2, o, 0, 0, 0); FRAG(fv, vbV, 3); o = __builtin_amdgcn_mfma_f32_32x32x16_bf16(fv, pa3, o, 0, 0, 0); }
#pragma unroll
        for (int d0 = 0; d0 < 8; ++d0) { const bf16x8 qf = *(const LAS bf16x8*)(Qi + KSWZ(tb * 32 + r32, (d0 * 16 + hi * 8) * 2));
            o = __builtin_amdgcn_mfma_f32_32x32x16_bf16(sf[d0], qf, o, 0, 0, 0); }
        { float ss = 0.f;
#pragma unroll
          for (int r = 0; r < 16; ++r) ss += o[r] * o[r];
          { const unsigned u = __builtin_bit_cast(unsigned, ss); auto sw = __builtin_amdgcn_permlane32_swap(u, u, false, false); ss = __builtin_bit_cast(float, (unsigned)sw[0]) + __builtin_bit_cast(float, (unsigned)sw[1]); }
          if (hi == 0) sst[(tb * 32 + r32) * 4 + vblk] = ss;
          __syncthreads();
          const f32x4 s4 = *(const LAS f32x4*)(sst + (tb * 32 + r32) * 4);
          const float rs = __builtin_amdgcn_rsqf(((s4[0] + s4[1]) + (s4[2] + s4[3])) * (1.0f / 128.0f) + RMS_EPS);
          float y[16];
#pragma unroll
          for (int g = 0; g < 4; ++g) {
              const float gg4[4] = {__builtin_bit_cast(float, g0[g].x << 16), __builtin_bit_cast(float, g0[g].x & 0xffff0000u), __builtin_bit_cast(float, g0[g].y << 16), __builtin_bit_cast(float, g0[g].y & 0xffff0000u)};
#pragma unroll
              for (int e = 0; e < 4; ++e) { const float gg = gg4[e]; y[4 * g + e] = o[4 * g + e] * rs * gn[g][e] * (gg * __builtin_amdgcn_rcpf(1.0f + __expf(-gg))); } }
          bf16* orow = ob + (r0 + tb * 32 + r32) * 2048 + h * 128 + 32 * vblk + hi * 8;
#pragma unroll
          for (int b8 = 0; b8 < 16; b8 += 8) {
              const unsigned a0_ = cvtpk_c(y[b8 + 0], y[b8 + 1]), a1_ = cvtpk_c(y[b8 + 2], y[b8 + 3]), b0_ = cvtpk_c(y[b8 + 4], y[b8 + 5]), b1_ = cvtpk_c(y[b8 + 6], y[b8 + 7]);
              auto r0_ = __builtin_amdgcn_permlane32_swap(a0_, b0_, false, false); auto r1_ = __builtin_amdgcn_permlane32_swap(a1_, b1_, false, false);
              *(v4u*)(orow + 2 * b8) = (v4u){r0_[0], r1_[0], r0_[1], r1_[1]}; } }
#pragma unroll
        for (int g = 0; g < 4; ++g) g0[g] = ng0[g];
    }
#undef C_LOAD
}
#undef KSWZ
#undef TRRD
#undef FRAG
}

struct Args { const float* in[19]; float* out; unsigned char* ws; int ph_lo, ph_hi, li, skip_mix; };

struct WDesc { const float* src; const float* gain; bf16* dst; int K, Nsrc, Nout, cmap; };
constexpr int NWMAT = 18;
__device__ __forceinline__ WDesc get_wdesc(int idx, const Args& a) {
    WDesc d; d.gain = nullptr; d.cmap = 0; unsigned char* ws = a.ws;
    if (idx < 2)       { d.src = a.in[5] + (size_t)idx * 2048 * 6144; d.K = 2048; d.Nsrc = d.Nout = 6144; d.gain = a.in[2] + (idx == 0 ? 0 : 3) * 2048; d.dst = (bf16*)(ws + W_SBQKV) + (size_t)idx * 6144 * 2048; }
    else if (idx < 4)  { const int j = idx - 2; d.src = a.in[6] + (size_t)j * 2048 * 2048; d.K = 2048; d.Nsrc = d.Nout = 2048; d.dst = (bf16*)(ws + W_SBWO) + (size_t)j * 2048 * 2048; }
    else if (idx == 4) { d.src = a.in[7]; d.K = 2048; d.Nsrc = d.Nout = 8192; d.gain = a.in[2] + 1 * 2048; d.dst = (bf16*)(ws + W_HGIN); }
    else if (idx == 5) { d.src = a.in[10]; d.K = 2048; d.Nsrc = d.Nout = 2048; d.dst = (bf16*)(ws + W_HGWO); }
    else if (idx == 6) { d.src = a.in[11]; d.K = 2048; d.Nsrc = 1344; d.Nout = 2048; d.gain = a.in[2] + 2 * 2048; d.cmap = 1; d.dst = (bf16*)(ws + W_DKV); }
    else if (idx == 7) { d.src = a.in[14]; d.K = 768; d.Nsrc = d.Nout = 3072; d.gain = a.in[12]; d.cmap = 2; d.dst = (bf16*)(ws + W_UQ); }
    else if (idx == 8) { d.src = a.in[15]; d.K = 512; d.Nsrc = d.Nout = 4096; d.gain = a.in[13]; d.dst = (bf16*)(ws + W_UKV); }
    else if (idx == 9) { d.src = a.in[16]; d.K = 2048; d.Nsrc = d.Nout = 2048; d.dst = (bf16*)(ws + W_MLAWO); }
    else if (idx < 14) { const int L = idx - 10; d.src = a.in[17] + (size_t)L * 2048 * 8192; d.K = 2048; d.Nsrc = d.Nout = 8192; d.gain = a.in[3] + L * 2048; d.dst = (bf16*)(ws + W_W1) + (size_t)L * 8192 * 2048; }
    else               { const int L = idx - 14; d.src = a.in[18] + (size_t)L * 8192 * 2048; d.K = 8192; d.Nsrc = d.Nout = 2048; d.dst = (bf16*)(ws + W_W2) + (size_t)L * 2048 * 8192; }
    return d;
}
__device__ __forceinline__ int wmap_col(int cmap, int n) {
    if (cmap == 1) { if (n < 1280) return n; if (n < 1344) { const int j = n - 1280; return 1280 + (j & 1) * 32 + (j >> 1); } return -1; }
    if (cmap == 2) { const int h = n / 192, c = n % 192; if (c < 128) return n; const int j = c - 128; return h * 192 + 128 + (j & 1) * 32 + (j >> 1); }
    return n;
}
__device__ __forceinline__ void p0_item_load(const WDesc& d, int item, int lane, float (&wv)[32]) {
    const int nblk = d.Nout / 32, kb = item / nblk, nb = item % nblk, k0 = 64 * kb, n0 = 32 * nb;
    const int src = wmap_col(d.cmap, n0 + (lane & 31));
    const float* sp = d.src + (size_t)(k0 + (lane >> 5)) * d.Nsrc + (src >= 0 ? src : 0);
#pragma unroll
    for (int i = 0; i < 32; ++i) wv[i] = __builtin_nontemporal_load(sp + (size_t)(2 * i) * d.Nsrc);
}
__device__ __forceinline__ void p0_item_store(const WDesc& d, LAS float* scr, int item, int lane, const float (&wv)[32]) {
    const int nblk = d.Nout / 32, kb = item / nblk, nb = item % nblk, k0 = 64 * kb, n0 = 32 * nb;
    const int src = wmap_col(d.cmap, n0 + (lane & 31));
#pragma unroll
    for (int i = 0; i < 32; ++i) { const int kk = 2 * i + (lane >> 5); scr[kk * 33 + (lane & 31)] = (src >= 0) ? wv[i] : 0.f; }
    LDS_WAIT(); asm volatile("" ::: "memory");
    const int c = lane & 7;
    f32x4 g0 = (f32x4){1.f, 1.f, 1.f, 1.f}, g1 = g0;
    if (d.gain) { g0 = *(const f32x4*)(d.gain + k0 + 8 * c); g1 = *(const f32x4*)(d.gain + k0 + 8 * c + 4); }
#pragma unroll
    for (int j = 0; j < 4; ++j) { const int n = (lane >> 3) + 8 * j; const LAS float* s = scr + (8 * c) * 33 + n;
        v4u o; o.x = pk2(s[0 * 33] * g0[0], s[1 * 33] * g0[1]); o.y = pk2(s[2 * 33] * g0[2], s[3 * 33] * g0[3]); o.z = pk2(s[4 * 33] * g1[0], s[5 * 33] * g1[1]); o.w = pk2(s[6 * 33] * g1[2], s[7 * 33] * g1[3]);
        *(GAS v4u*)(d.dst + (size_t)(n0 + n) * d.K + k0 + 8 * c) = o; }
    LDS_WAIT(); asm volatile("" ::: "memory");
}
__device__ __forceinline__ void p0_prologue(const Args& a, LAS unsigned char* lds, int vcu, int NGW) {
    int tid_ = threadIdx.x; asm volatile("" : "+v"(tid_)); const int lane = tid_ & 63, wave = __builtin_amdgcn_readfirstlane(tid_ >> 6), gw = vcu * NWAVES + wave;
    LAS float* scr = (LAS float*)(lds + RING_OFF + wave * 16384);
    int off = 0;
#define CONVERT_W(w) { const WDesc d = get_wdesc(w, a); const int cnt = (d.K / 64) * (d.Nout / 32); int it = ((gw - off) % NGW + NGW) % NGW; float wa[32], wb[32]; \
        if (it < cnt) p0_item_load(d, it, lane, wa); \
        for (; it < cnt; it += 2 * NGW) { if (it + NGW < cnt) p0_item_load(d, it + NGW, lane, wb); p0_item_store(d, scr, it, lane, wa); \
            if (it + NGW < cnt) { if (it + 2 * NGW < cnt) p0_item_load(d, it + 2 * NGW, lane, wa); p0_item_store(d, scr, it + NGW, lane, wb); } } off += cnt; }
    CONVERT_W(0) CONVERT_W(1) CONVERT_W(2) CONVERT_W(3) CONVERT_W(4) CONVERT_W(5) CONVERT_W(6) CONVERT_W(7) CONVERT_W(8) CONVERT_W(9)
    CONVERT_W(10) CONVERT_W(11) CONVERT_W(12) CONVERT_W(13) CONVERT_W(14) CONVERT_W(15) CONVERT_W(16) CONVERT_W(17)
#undef CONVERT_W
    pg8::u64* rowss = (pg8::u64*)(a.ws + WS_CTL + CTL_ROWSS); bf16* ab = (bf16*)(a.ws + WS_AB);
    for (int m = gw; m < M; m += NGW) {
        const GAS f32x4* xr = (const GAS f32x4*)(a.in[0] + (size_t)m * DM) + lane; GAS v2u* o8 = (GAS v2u*)(ab + (size_t)m * DM) + lane;
        f32x4 v[8]; float s = 0.f;
#pragma unroll
        for (int j = 0; j < 8; ++j) { v[j] = __builtin_nontemporal_load(xr + 64 * j); s += pg8::dot4(v[j]); }
        s = wave_sum(s);
#pragma unroll
        for (int j = 0; j < 8; ++j) { v2u w; w.x = pk2(v[j][0], v[j][1]); w.y = pk2(v[j][2], v[j][3]); o8[64 * j] = w; }
        if (lane == 0) rowss[m] = (pg8::u64)(long long)((double)s * pg8::RSS_FIX);
    }
    { const int* pos = (const int*)a.in[1]; float* cs = (float*)(a.ws + WS_CS);
      for (int e = gw * 64 + lane; e < M * 32; e += NGW * 64) { const int row = e >> 5, i = e & 31;
          const float inv_freq = exp2f(-(float)(2 * i) * (13.287712379549449f / 64.0f));
          const float ang = (float)pos[row] * inv_freq;
          double t = (double)ang * 0.15915494309189535; t -= floor(t);
          const float fr = (float)t;
          f32x2 o; o.x = __builtin_amdgcn_cosf(fr); o.y = __builtin_amdgcn_sinf(fr);
          *(f32x2*)(cs + (size_t)e * 2) = o; } }
    { const float* lg = a.in[8]; float* tab = (float*)(a.ws + WS_TAB);
      for (int c = gw * 64 + lane; c < 2048; c += NGW * 64) {
          const float l0 = lg[c], l1 = lg[2048 + c], l2 = lg[4096 + c], l3 = lg[6144 + c];
          const float mx = fmaxf(fmaxf(l0, l1), fmaxf(l2, l3));
          const float e0 = expf(l0 - mx), e1 = expf(l1 - mx), e2 = expf(l2 - mx), e3 = expf(l3 - mx); const float sum = (e0 + e1) + (e2 + e3);
          const float p0 = e0 / sum, p1 = e1 / sum; const float lb = (p0 + p1) - p0;
          tab[c] = logf(lb); tab[2048 + c] = log1pf(-lb); tab[4096 + c] = lb; tab[6144 + c] = 1.0f - lb; } }
}
__device__ __forceinline__ void final_norm_phase(const Args& a, int vcu, int NGW) {
    int tid_ = threadIdx.x; asm volatile("" : "+v"(tid_)); const int lane = tid_ & 63, gw = vcu * NWAVES + __builtin_amdgcn_readfirstlane(tid_ >> 6);
    const pg8::u64* rowss = (const pg8::u64*)(a.ws + WS_CTL + CTL_ROWSS) + 8 * (size_t)M; const float* gn = a.in[4];
    f32x4 g[8];
#pragma unroll
    for (int j = 0; j < 4; ++j) { g[2 * j] = *((const f32x4*)gn + 2 * (64 * j + lane)); g[2 * j + 1] = *((const f32x4*)gn + 2 * (64 * j + lane) + 1); }
    const bf16* ab = (const bf16*)(a.ws + WS_AB);
    for (int m = gw; m < M; m += 2 * NGW) {
        const int m1 = (m + NGW < M) ? m + NGW : m;
        const GAS v4u* h0 = (const GAS v4u*)(ab + (size_t)m * DM) + lane; const GAS v4u* h1 = (const GAS v4u*)(ab + (size_t)m1 * DM) + lane;
        v4u w0[4], w1[4];
#pragma unroll
        for (int j = 0; j < 4; ++j) { w0[j] = h0[64 * j]; w1[j] = h1[64 * j]; }
        const float rs0 = 1.0f / sqrtf(pg8::rowss_get(rowss + m) * (1.0f / DM) + RMS_EPS), rs1 = 1.0f / sqrtf(pg8::rowss_get(rowss + m1) * (1.0f / DM) + RMS_EPS);
        GAS f32x4* x0 = (GAS f32x4*)(a.out + (size_t)m * DM) + 2 * lane; GAS f32x4* x1 = (GAS f32x4*)(a.out + (size_t)m1 * DM) + 2 * lane;
#pragma unroll
        for (int j = 0; j < 4; ++j) {
            { const v4u w = w0[j]; f32x4 lo, hi4; lo[0] = __builtin_bit_cast(float, w.x << 16); lo[1] = __builtin_bit_cast(float, w.x & 0xffff0000u); lo[2] = __builtin_bit_cast(float, w.y << 16); lo[3] = __builtin_bit_cast(float, w.y & 0xffff0000u);
              hi4[0] = __builtin_bit_cast(float, w.z << 16); hi4[1] = __builtin_bit_cast(float, w.z & 0xffff0000u); hi4[2] = __builtin_bit_cast(float, w.w << 16); hi4[3] = __builtin_bit_cast(float, w.w & 0xffff0000u);
              x0[128 * j] = lo * rs0 * g[2 * j]; x0[128 * j + 1] = hi4 * rs0 * g[2 * j + 1]; }
            if (m1 != m) { const v4u w = w1[j]; f32x4 lo, hi4; lo[0] = __builtin_bit_cast(float, w.x << 16); lo[1] = __builtin_bit_cast(float, w.x & 0xffff0000u); lo[2] = __builtin_bit_cast(float, w.y << 16); lo[3] = __builtin_bit_cast(float, w.y & 0xffff0000u);
              hi4[0] = __builtin_bit_cast(float, w.z << 16); hi4[1] = __builtin_bit_cast(float, w.z & 0xffff0000u); hi4[2] = __builtin_bit_cast(float, w.w << 16); hi4[3] = __builtin_bit_cast(float, w.w & 0xffff0000u);
              x1[128 * j] = lo * rs1 * g[2 * j]; x1[128 * j + 1] = hi4 * rs1 * g[2 * j + 1]; }
        }
    }
}

#ifndef WGM_G1
#define WGM_G1 4
#define WGM_UQ 4
#define WGM_WO 4
#define WGM_W1 4
#define WGM_W2 4
#endif
constexpr int PH_FINAL = 33, PH_END = 34;
__host__ __device__ __forceinline__ constexpr int ph_id(int L, int s) { return 1 + 8 * L + s; }

__global__ void __launch_bounds__(NWAVES * 64, 2) trunk_fwd(Args args) {
    extern __shared__ __attribute__((aligned(16))) unsigned char lds_raw[];
    LAS unsigned char* lds = (LAS unsigned char*)lds_raw;
    volatile LAS unsigned* MISC = (volatile LAS unsigned*)(lds + MISC_OFF);
    const int tid = threadIdx.x;
    const int G = gridDim.x; const int bx = blockIdx.x; const int vcu = (G % 8 == 0) ? (bx % 8) * (G / 8) + bx / 8 : bx;
    const int NGW = G * NWAVES;
    unsigned char* ws = args.ws;
    gu32* ctl = (gu32*)(ws + WS_CTL);
    for (int u = tid; u < (LDS_BYTES - LDSCTL_OFF) / 4; u += NWAVES * 64) ((LAS unsigned*)(lds + LDSCTL_OFF))[u] = 0u;
    __syncthreads();
    XcdBarrier bar = xcd_barrier_post((unsigned*)(ctl + CW_BAR) + args.li * XCD_BAR_WORDS, MISC + 8);
    const int lo = args.ph_lo, hi = args.ph_hi;
#define IN(k) (lo <= (k) && (k) < hi)
#define END_PHASE(k) do { if (hi > (k) + 1) xcd_barrier(bar); } while (0)

    bf16* abuf = (bf16*)(ws + WS_AB); bf16* obuf = (bf16*)(ws + WS_OB); unsigned char* big = ws + WS_BIG;

    if (IN(0)) { p0_prologue(args, lds, vcu, NGW); END_PHASE(0); }

    for (int L = 0; L < DEPTH; ++L) {
        const int type = L % 3, j = L / 3;
        const bool own_mix = ((args.skip_mix >> type) & 1) == 0;
        if (IN(ph_id(L, 0))) {
            pg8::EpiMulti E{}; E.rs_idx = 2 * L; E.inv_k = 1.0f / DM; E.ws = ws; E.qscale = 1.f;
            pg8::Gemm g; g.A = abuf; g.M = M; g.K = DM;
            if (type == 0)      { g.Bt = (const bf16*)(ws + W_SBQKV) + (size_t)j * 6144 * 2048; g.N = 6144; E.mode = pg8::EM_SBQKV; E.qscale = 0.08838834764831845f * LOG2E; }
            else if (type == 1) { g.Bt = (const bf16*)(ws + W_HGIN); g.N = 8192; E.mode = pg8::EM_HG; }
            else                { g.Bt = (const bf16*)(ws + W_DKV); g.N = MLA_DKV_NP; E.mode = pg8::EM_DKV; }
            pg8::StaticOrder S; S.init(M, g.N, G, bx, WGM_G1);
            pg8::gemm_phase<pg8::EpiMulti, pg8::StaticOrder, true, true>(lds + RING_OFF, g, S, E);
            END_PHASE(ph_id(L, 0));
        }
        if (type == 2 && IN(ph_id(L, 1))) {
            { pg8::EpiMulti E{}; E.mode = pg8::EM_UQ; E.rs_idx = RS_Q; E.inv_k = 1.0f / MLA_QR; E.ws = ws; E.qscale = 0.07216878364870322f * LOG2E;
              pg8::Gemm g; g.A = (const bf16*)(big + BIG_CQ); g.Bt = (const bf16*)(ws + W_UQ); g.M = M; g.N = 3072; g.K = MLA_QR;
              pg8::StaticOrder S; S.init(M, g.N, G, bx, WGM_UQ);
              pg8::gemm_phase<pg8::EpiMulti, pg8::StaticOrder, true, true>(lds + RING_OFF, g, S, E); }
            { pg8::EpiMulti E{}; E.mode = pg8::EM_UKV; E.rs_idx = RS_KV; E.inv_k = 1.0f / MLA_KVR; E.ws = ws; E.qscale = 1.f;
              pg8::Gemm g; g.A = (const bf16*)(big + BIG_CKV); g.Bt = (const bf16*)(ws + W_UKV); g.M = M; g.N = 4096; g.K = MLA_KVR;
              pg8::StaticOrder S; S.init(M, g.N, G, bx, WGM_UQ);
              pg8::gemm_phase<pg8::EpiMulti, pg8::StaticOrder, true, true>(lds + RING_OFF, g, S, E); }
            END_PHASE(ph_id(L, 1));
        }
        if (type == 0 && own_mix && IN(ph_id(L, 1))) {
            att::sb_phase((const bf16*)(big + BIG_QKV), obuf, lds + RING_OFF, vcu, G);
            END_PHASE(ph_id(L, 1));
        }
        if (type == 1 && own_mix) {
            if (IN(ph_id(L, 1))) { hg::pass_a((const bf16*)(big + BIG_HI), (const float*)(big + BIG_HLF), (bf16*)(big + BIG_HKVS), (float*)(big + BIG_HDEC), lds + RING_OFF, vcu, G); END_PHASE(ph_id(L, 1)); }
            if (IN(ph_id(L, 2))) { hg::pass_b((bf16*)(big + BIG_HKVS), (const float*)(big + BIG_HDEC), lds + RING_OFF, vcu, G); END_PHASE(ph_id(L, 2)); }
            if (IN(ph_id(L, 3))) { hg::pass_c((const bf16*)(big + BIG_HQ), (const bf16*)(big + BIG_HI), (const bf16*)(big + BIG_HG), (const float*)(big + BIG_HLF), (const bf16*)(big + BIG_HKVS), args.in[9], obuf, lds + RING_OFF, vcu, G);
                                   END_PHASE(ph_id(L, 3)); }
        }
        if (type == 2 && own_mix && IN(ph_id(L, 2))) {
            att::mla_phase((const bf16*)(big + BIG_QM), (const bf16*)(big + BIG_KVM), (const bf16*)(big + BIG_KPE), obuf, lds + RING_OFF, vcu, G);
            END_PHASE(ph_id(L, 2));
        }
        if (IN(ph_id(L, 4))) {
            pg8::Gemm g; g.A = obuf; g.M = M; g.N = DM; g.K = DM;
            g.Bt = (type == 0) ? (const bf16*)(ws + W_SBWO) + (size_t)j * 2048 * 2048 : (type == 1) ? (const bf16*)(ws + W_HGWO) : (const bf16*)(ws + W_MLAWO);
            pg8::EpiResid E{(L == 0) ? args.in[0] : nullptr, ws, 2 * L + 1};
            pg8::StaticOrder S; S.init(M, g.N, G, bx, WGM_WO);
            pg8::gemm_phase<pg8::EpiResid, pg8::StaticOrder, true, true>(lds + RING_OFF, g, S, E);
            END_PHASE(ph_id(L, 4));
        }
        if (IN(ph_id(L, 5))) {
            pg8::EpiMulti E{}; E.mode = pg8::EM_RELU2; E.rs_idx = 2 * L + 1; E.inv_k = 1.0f / DM; E.ws = ws; E.qscale = 1.f;
            pg8::Gemm g; g.A = abuf; g.Bt = (const bf16*)(ws + W_W1) + (size_t)L * 8192 * 2048; g.M = M; g.N = DFF; g.K = DM;
            pg8::StaticOrder S; S.init(M, g.N, G, bx, WGM_W1);
            pg8::gemm_phase<pg8::EpiMulti, pg8::StaticOrder, true, true>(lds + RING_OFF, g, S, E);
            END_PHASE(ph_id(L, 5));
        }
        if (IN(ph_id(L, 6))) {
            pg8::Gemm g; g.A = (const bf16*)(big + BIG_HID); g.Bt = (const bf16*)(ws + W_W2) + (size_t)L * 2048 * 8192; g.M = M; g.N = DM; g.K = DFF;
            pg8::EpiResid E{nullptr, ws, 2 * L + 2};
            pg8::StaticOrder S; S.init(M, g.N, G, bx, WGM_W2, 1);
            pg8::gemm_phase<pg8::EpiResid, pg8::StaticOrder, true, true>(lds + RING_OFF, g, S, E);
            END_PHASE(ph_id(L, 6));
        }
    }
    if (IN(PH_FINAL)) final_norm_phase(args, vcu, NGW);
#undef IN
#undef END_PHASE
}

extern "C" void kernel_launch(void* const* d_in, const int* in_sizes, int n_in, void* d_out, int out_size, void* d_ws, size_t ws_size, hipStream_t stream) {
    static int grid = 0;
    if (grid == 0) {
        if (n_in != 19 || in_sizes[0] != M * DM || out_size != M * DM || ws_size < WS_END) { fprintf(stderr, "kernel_launch: unexpected shapes (n_in %d, in0 %d, out %d, ws %zu < %zu)\n", n_in, n_in > 0 ? in_sizes[0] : -1, out_size, ws_size, (size_t)WS_END); grid = -1; return; }
        int dev = 0, cus = 0, per_cu = 0;
        if (hipGetDevice(&dev) != hipSuccess || hipDeviceGetAttribute(&cus, hipDeviceAttributeMultiprocessorCount, dev) != hipSuccess) { grid = -1; return; }
        if (hipFuncSetAttribute((const void*)trunk_fwd, hipFuncAttributeMaxDynamicSharedMemorySize, LDS_BYTES) != hipSuccess) { fprintf(stderr, "kernel_launch: hipFuncSetAttribute failed\n"); grid = -1; return; }
        if (hipOccupancyMaxActiveBlocksPerMultiprocessor(&per_cu, (const void*)trunk_fwd, NWAVES * 64, LDS_BYTES) != hipSuccess || per_cu < 1) fprintf(stderr, "kernel_launch: occupancy query says %d\n", per_cu);
        (void)hipGetLastError();
        grid = cus;
    }
    if (grid < 0) return;
    (void)hipMemsetAsync((char*)d_ws + WS_CTL, 0, CTL_ZERO_BYTES, stream);
    Args a{};
    for (int i = 0; i < 19; ++i) a.in[i] = (const float*)d_in[i];
    a.out = (float*)d_out; a.ws = (unsigned char*)d_ws;
    a.ph_lo = 0; a.ph_hi = PH_END; a.li = 0; a.skip_mix = 0;
    hipLaunchKernelGGL(trunk_fwd, dim3(grid), dim3(NWAVES * 64), LDS_BYTES, stream, a);
}
```

```cpp
#include <hip/hip_runtime.h>
#include <cstdio>
#include <cstdint>

constexpr int NWAVES = 8;
constexpr int BATCH = 2, SEQ = 8192, DM = 2048, DEPTH = 4, M = BATCH * SEQ;
constexpr int NH = 16, HD = 128, DFF = 8192;
constexpr int MLA_QR = 768, MLA_KVR = 512, MLA_ROPE = 64, MLA_NOPE = 128, MLA_QK = 192, MLA_DKV_N = 1344, MLA_DKV_NP = 2048;
constexpr int CHUNK = 64, NCHUNK = SEQ / CHUNK;
constexpr float RMS_EPS = 1e-6f;
constexpr float LOG2E = 1.4426950408889634f;

constexpr size_t MiB = 1u << 20;
constexpr size_t WS_CTL = 0, CTL_ZERO_BYTES = 2 * MiB;
constexpr int CW_TMO = 0, CW_BAR = 4096;
constexpr size_t CTL_ROWSS = 256 * 1024;
constexpr int RS_Q = 9, RS_KV = 10;
constexpr size_t WS_TAB = 2 * MiB;
constexpr size_t WS_CS = 3 * MiB;
constexpr size_t WS_W = 7 * MiB;
constexpr size_t W_SBQKV = WS_W;
constexpr size_t W_SBWO = W_SBQKV + 2 * (size_t)6144 * 2048 * 2;
constexpr size_t W_HGIN = W_SBWO + 2 * (size_t)2048 * 2048 * 2;
constexpr size_t W_HGWO = W_HGIN + (size_t)8192 * 2048 * 2;
constexpr size_t W_DKV = W_HGWO + (size_t)2048 * 2048 * 2;
constexpr size_t W_UQ = W_DKV + (size_t)2048 * 2048 * 2;
constexpr size_t W_UKV = W_UQ + (size_t)3072 * 768 * 2;
constexpr size_t W_MLAWO = W_UKV + (size_t)4096 * 512 * 2;
constexpr size_t W_W1 = W_MLAWO + (size_t)2048 * 2048 * 2;
constexpr size_t W_W2 = W_W1 + 4 * (size_t)8192 * 2048 * 2;
constexpr size_t W_END = W_W2 + 4 * (size_t)8192 * 2048 * 2;
constexpr size_t WS_AB = 392 * MiB;
constexpr size_t WS_OB = WS_AB + 64 * MiB;
constexpr size_t WS_BIG = WS_OB + 64 * MiB;
static_assert(W_END <= WS_AB, "weights fit");
constexpr size_t BIG_QKV = 0;
constexpr size_t BIG_HID = 0;
constexpr size_t BIG_HQ = 0, BIG_HI = 64 * MiB, BIG_HG = 128 * MiB, BIG_HLF = 192 * MiB, BIG_HKVS = 320 * MiB;
constexpr size_t BIG_HDEC = 448 * MiB;
constexpr size_t BIG_CQ = 0, BIG_CKV = 24 * MiB, BIG_KPE = 40 * MiB, BIG_QM = 48 * MiB, BIG_KVM = 144 * MiB;
constexpr size_t WS_END = WS_BIG + 452 * MiB;
static_assert(WS_END <= (size_t)1024 * MiB, "workspace map inside 1 GiB");

constexpr int RING_OFF = 0, RING_BYTES = 131072;
constexpr int LDSCTL_OFF = RING_BYTES, MISC_OFF = LDSCTL_OFF + 320;
constexpr int LDS_BYTES = 147456;

namespace pg8 {
#define PG8_LAS __attribute__((address_space(3)))
typedef unsigned short bf16_t;
typedef short bf16x8 __attribute__((ext_vector_type(8)));
typedef float f32x4 __attribute__((ext_vector_type(4)));
typedef unsigned u32x4 __attribute__((ext_vector_type(4)));
constexpr int BM = 256, BK = 64, HALF = 128, HTB = HALF * BK * 2  , STAGE_BYTES = 8 * HTB, NXCD = 8;

__host__ __device__ __forceinline__ int lds_byte(int r, int c) { const int st = (r >> 4) * 2 + (c >> 5), rr = r & 15, cc = c & 31, ob = rr * 64 + cc * 2; return st * 1024 + (ob ^ (((ob >> 9) & 1) << 5)); }
__host__ __device__ __forceinline__ void stage_rc(int b, int& R, int& C) { const int st = b / 1024, sb = b % 1024, swz = sb ^ (((sb >> 9) & 1) << 5); R = (st >> 1) * 16 + swz / 64; C = (st & 1) * 32 + (swz % 64) / 2; }
__host__ __device__ __forceinline__ int perm32(int rho) { const int n = rho >> 4, i = rho & 15; return 8 * (i >> 2) + 4 * n + (i & 3); }

struct Unit { int pm, pn; };
struct Gemm { const bf16_t* A; const bf16_t* Bt; int M, N, K; };

struct StaticOrder {
    int nM, nN, nwg, G, c, WGM, rev;
    __host__ __device__ void init(int M, int N, int G_, int c_, int wgm = 4, int rev_ = 0) { nM = M / BM; nN = N / BM; nwg = nM * nN; G = G_; c = c_; WGM = wgm; rev = rev_; }
    __host__ __device__ bool next(int i, Unit& u) const {
        const long L = (long)i * G + c; if (L >= nwg) return false;
        int wgid = (int)L; { const int q = nwg / NXCD, r = nwg % NXCD, xcd = wgid % NXCD, off = wgid / NXCD; wgid = (xcd < r ? xcd * (q + 1) : r * (q + 1) + (xcd - r) * q) + off; }
        const int nig = WGM * nN, gid = wgid / nig, fm = gid * WGM, gsz = (nM - fm) < WGM ? (nM - fm) : WGM;
        u.pm = fm + ((wgid % nig) % gsz); u.pn = (wgid % nig) / gsz; if (rev) u.pm = nM - 1 - u.pm; return true;
    }
    __device__ __forceinline__ void a_ready(const Unit&) const {}
    __device__ __forceinline__ void done(const Unit&) const {}
};
__device__ __forceinline__ unsigned cvt_pk_bf16(float lo, float hi) { unsigned r; asm volatile("v_cvt_pk_bf16_f32 %0, %1, %2" : "=v"(r) : "v"(lo), "v"(hi)); return r; }
constexpr size_t KWS_AB = WS_AB, KCTL_ROWSS = WS_CTL + CTL_ROWSS, KWS_BIG = WS_BIG, KWS_CS = WS_CS, KWS_TAB = WS_TAB, KM = M;
constexpr size_t KBIG_QKV = BIG_QKV, KBIG_HID = BIG_HID, KBIG_HQ = BIG_HQ, KBIG_HI = BIG_HI, KBIG_HG = BIG_HG, KBIG_HLF = BIG_HLF, KBIG_CQ = BIG_CQ, KBIG_CKV = BIG_CKV, KBIG_KPE = BIG_KPE, KBIG_QM = BIG_QM, KBIG_KVM = BIG_KVM;
__device__ __forceinline__ u32x4 pack8_bf16(const f32x4 a, const f32x4 b) { u32x4 w; w.x = cvt_pk_bf16(a[0], a[1]); w.y = cvt_pk_bf16(a[2], a[3]); w.z = cvt_pk_bf16(b[0], b[1]); w.w = cvt_pk_bf16(b[2], b[3]); return w; }
__device__ __forceinline__ float dot4(const f32x4 a) { return (a[0] * a[0] + a[1] * a[1]) + (a[2] * a[2] + a[3] * a[3]); }
typedef unsigned long long u64;
constexpr double RSS_FIX = 16777216.0;
__device__ __forceinline__ void rowss_add(u64* p, float v) {
    const float hf = floorf(v * 0.00390625f); const float rem = fmaf(-256.0f, hf, v);
    const u64 q = ((u64)(unsigned)hf << 32) | (u64)(unsigned)(rem * 16777216.0f);
    const u64 old = __hip_atomic_fetch_add(p, q, __ATOMIC_RELAXED, __HIP_MEMORY_SCOPE_AGENT);
    asm volatile("" :: "v"(old));
}
__device__ __forceinline__ float rowss_cvt(u64 v) { return (float)((double)(long long)v * (1.0 / RSS_FIX)); }
__device__ __forceinline__ float rowss_get(const u64* p) { return rowss_cvt(*p); }
__device__ __forceinline__ float rowss_rs(u64 v, float inv_k) { const float f = (float)(unsigned)(v >> 32) * 256.0f + (float)(unsigned)v * (float)(1.0 / RSS_FIX); return __builtin_amdgcn_rsqf(f * inv_k + 1e-6f); }

__device__ __forceinline__ float quad16_sum(float v) {
    { const unsigned u = __builtin_bit_cast(unsigned, v); auto r = __builtin_amdgcn_permlane16_swap(u, u, false, false); v = __builtin_bit_cast(float, (unsigned)r[0]) + __builtin_bit_cast(float, (unsigned)r[1]); }
    { const unsigned u = __builtin_bit_cast(unsigned, v); auto r = __builtin_amdgcn_permlane32_swap(u, u, false, false); v = __builtin_bit_cast(float, (unsigned)r[0]) + __builtin_bit_cast(float, (unsigned)r[1]); }
    return v;
}
__device__ __forceinline__ f32x4 bf16x4_lo(const u32x4 w, int half) { f32x4 r; const unsigned a = half ? w.z : w.x, b = half ? w.w : w.y;
    r[0] = __builtin_bit_cast(float, a << 16); r[1] = __builtin_bit_cast(float, a & 0xffff0000u); r[2] = __builtin_bit_cast(float, b << 16); r[3] = __builtin_bit_cast(float, b & 0xffff0000u); return r; }
struct EpiResid {
    static constexpr bool PERM = true, AFTER_DRAIN = false;
    const float* x0; unsigned char* ws; int rs_idx;
    struct Pref {};
    __device__ __forceinline__ void prefetch(const Unit&, int, int, Pref&) const {}
    __device__ __forceinline__ void operator()(const f32x4 (&acc)[2][2][4][2], const Unit& u, int wr, int wc, int fr, int fq, const Pref&) const {
        const int row0 = u.pm * BM + wr * 64 + fr, col0 = u.pn * BM + wc * 32 + 8 * fq;
        bf16_t* ab = (bf16_t*)(ws + KWS_AB); u64* rowss = (u64*)(ws + KCTL_ROWSS) + (size_t)rs_idx * KM;
        if (x0) {
#pragma unroll
            for (int ai = 0; ai < 2; ++ai) {
                f32x4 r[4][2][2];
#pragma unroll
                for (int m = 0; m < 4; ++m)
#pragma unroll
                    for (int bj = 0; bj < 2; ++bj) { const float* p = x0 + (size_t)(row0 + ai * HALF + m * 16) * 2048 + col0 + bj * HALF; r[m][bj][0] = *(const f32x4*)p; r[m][bj][1] = *(const f32x4*)(p + 4); }
#pragma unroll
                for (int m = 0; m < 4; ++m) {
                    const int row = row0 + ai * HALF + m * 16; const size_t off = (size_t)row * 2048 + col0; float ss = 0.f;
#pragma unroll
                    for (int bj = 0; bj < 2; ++bj) {
                        const f32x4 v0 = r[m][bj][0] + acc[ai][bj][m][0], v1 = r[m][bj][1] + acc[ai][bj][m][1];
                        ss += dot4(v0) + dot4(v1);
                        *(u32x4*)(ab + off + bj * HALF) = pack8_bf16(v0, v1);
                    }
                    ss = quad16_sum(ss);
                    if (fq == 0) rowss_add(rowss + row, ss);
                }
                asm volatile("" ::: "memory");
            }
        } else {
            u32x4 w[2][4][2];
#pragma unroll
            for (int ai = 0; ai < 2; ++ai)
#pragma unroll
                for (int m = 0; m < 4; ++m)
#pragma unroll
                    for (int bj = 0; bj < 2; ++bj) w[ai][m][bj] = *(const u32x4*)(ab + (size_t)(row0 + ai * HALF + m * 16) * 2048 + col0 + bj * HALF);
#pragma unroll
            for (int ai = 0; ai < 2; ++ai)
#pragma unroll
                for (int m = 0; m < 4; ++m) {
                    const int row = row0 + ai * HALF + m * 16; const size_t off = (size_t)row * 2048 + col0; float ss = 0.f;
#pragma unroll
                    for (int bj = 0; bj < 2; ++bj) {
                        const f32x4 v0 = bf16x4_lo(w[ai][m][bj], 0) + acc[ai][bj][m][0], v1 = bf16x4_lo(w[ai][m][bj], 1) + acc[ai][bj][m][1];
                        ss += dot4(v0) + dot4(v1);
                        *(u32x4*)(ab + off + bj * HALF) = pack8_bf16(v0, v1);
                    }
                    ss = quad16_sum(ss);
                    if (fq == 0) rowss_add(rowss + row, ss);
                }
        }
    }
};

enum { EM_SBQKV = 0, EM_RELU2 = 1, EM_HG = 2, EM_DKV = 3, EM_UQ = 4, EM_UKV = 5 };
struct EpiMulti {
    static constexpr bool PERM = true, AFTER_DRAIN = false;
    int mode, rs_idx; float inv_k, qscale; unsigned char* ws;
    struct Pref { u64 v[2][4]; };
    __device__ __forceinline__ void prefetch(const Unit& u, int wr, int fr, Pref& p) const {
        const u64* r = (const u64*)(ws + KCTL_ROWSS) + (size_t)rs_idx * KM + u.pm * BM + wr * 64 + fr;
#pragma unroll
        for (int ai = 0; ai < 2; ++ai)
#pragma unroll
            for (int m = 0; m < 4; ++m) p.v[ai][m] = r[ai * HALF + m * 16];
    }
    __device__ __forceinline__ void operator()(const f32x4 (&acc)[2][2][4][2], const Unit& u, int wr, int wc, int fr, int fq, const Pref& pf) const {
        const int row0 = u.pm * BM + wr * 64 + fr, colt = u.pn * BM, lc = wc * 32 + 8 * fq;
        unsigned char* big = ws + KWS_BIG; const float* cs = (const float*)(ws + KWS_CS);
#pragma unroll
        for (int ai = 0; ai < 2; ++ai)
#pragma unroll
            for (int m = 0; m < 4; ++m) {
                const int row = row0 + ai * HALF + m * 16;
                const float rs = rowss_rs(pf.v[ai][m], inv_k);
                float ss = 0.f;
#pragma unroll
                for (int bj = 0; bj < 2; ++bj) {
                    f32x4 v0 = acc[ai][bj][m][0] * rs, v1 = acc[ai][bj][m][1] * rs;
                    const int col = colt + bj * HALF + lc;
                    if (mode == EM_SBQKV) {
                        if (col < 2048) { v0 = v0 * qscale; v1 = v1 * qscale; }
                        *(u32x4*)((bf16_t*)(big + KBIG_QKV) + (size_t)row * 6144 + col) = pack8_bf16(v0, v1);
                    } else if (mode == EM_RELU2) {
#pragma unroll
                        for (int e = 0; e < 4; ++e) { v0[e] = fmaxf(v0[e], 0.f); v1[e] = fmaxf(v1[e], 0.f); }
                        v0 = v0 * v0; v1 = v1 * v1;
                        *(u32x4*)((bf16_t*)(big + KBIG_HID) + (size_t)row * 8192 + col) = pack8_bf16(v0, v1);
                    } else if (mode == EM_HG) {
                        const int t = col >> 11, c = col & 2047;
                        if (t == 1) {
                            const float* lbt = (const float*)(ws + KWS_TAB) + 4096; const float* omlt = lbt + 2048;
                            const f32x4 la0 = *(const f32x4*)(lbt + c), la1 = *(const f32x4*)(lbt + c + 4), lm0 = *(const f32x4*)(omlt + c), lm1 = *(const f32x4*)(omlt + c + 4);
                            f32x4 o0, o1;
#pragma unroll
                            for (int e = 0; e < 4; ++e) {
                                o0[e] = __logf(fmaf(lm0[e], __builtin_amdgcn_rcpf(1.f + __expf(-v0[e])), la0[e]));
                                o1[e] = __logf(fmaf(lm1[e], __builtin_amdgcn_rcpf(1.f + __expf(-v1[e])), la1[e]));
                            }
                            float* lf = (float*)(big + KBIG_HLF); *(f32x4*)(lf + (size_t)row * 2048 + c) = o0; *(f32x4*)(lf + (size_t)row * 2048 + c + 4) = o1;
                        } else {
                            bf16_t* dst = (bf16_t*)(big + ((t == 0) ? KBIG_HQ : (t == 2) ? KBIG_HI : KBIG_HG));
                            *(u32x4*)(dst + (size_t)row * 2048 + c) = pack8_bf16(v0, v1);
                        }
                    } else if (mode == EM_DKV) {
                        if (col < 768) { ss += dot4(v0) + dot4(v1); *(u32x4*)((bf16_t*)(big + KBIG_CQ) + (size_t)row * 768 + col) = pack8_bf16(v0, v1); }
                        else if (col < 1280) { ss += dot4(v0) + dot4(v1); *(u32x4*)((bf16_t*)(big + KBIG_CKV) + (size_t)row * 512 + (col - 768)) = pack8_bf16(v0, v1); }
                        else if (col < 1344) {
                            const int i0 = (col - 1280) >> 1;
                            const f32x4 c0 = *(const f32x4*)(cs + (size_t)row * 64 + 2 * i0), c1 = *(const f32x4*)(cs + (size_t)row * 64 + 2 * i0 + 4);
                            f32x4 o0, o1;
                            o0[0] = v0[0] * c0[0] - v0[1] * c0[1]; o0[1] = v0[0] * c0[1] + v0[1] * c0[0]; o0[2] = v0[2] * c0[2] - v0[3] * c0[3]; o0[3] = v0[2] * c0[3] + v0[3] * c0[2];
                            o1[0] = v1[0] * c1[0] - v1[1] * c1[1]; o1[1] = v1[0] * c1[1] + v1[1] * c1[0]; o1[2] = v1[2] * c1[2] - v1[3] * c1[3]; o1[3] = v1[2] * c1[3] + v1[3] * c1[2];
                            *(u32x4*)((bf16_t*)(big + KBIG_KPE) + (size_t)row * 64 + (col - 1280)) = pack8_bf16(o0, o1);
                        }
                    } else if (mode == EM_UQ) {
                        v0 = v0 * qscale; v1 = v1 * qscale;
                        const int cc = col % 192;
                        if (cc >= 128) {
                            const int i0 = (cc - 128) >> 1;
                            const f32x4 c0 = *(const f32x4*)(cs + (size_t)row * 64 + 2 * i0), c1 = *(const f32x4*)(cs + (size_t)row * 64 + 2 * i0 + 4);
                            f32x4 o0, o1;
                            o0[0] = v0[0] * c0[0] - v0[1] * c0[1]; o0[1] = v0[0] * c0[1] + v0[1] * c0[0]; o0[2] = v0[2] * c0[2] - v0[3] * c0[3]; o0[3] = v0[2] * c0[3] + v0[3] * c0[2];
                            o1[0] = v1[0] * c1[0] - v1[1] * c1[1]; o1[1] = v1[0] * c1[1] + v1[1] * c1[0]; o1[2] = v1[2] * c1[2] - v1[3] * c1[3]; o1[3] = v1[2] * c1[3] + v1[3] * c1[2];
                            v0 = o0; v1 = o1;
                        }
                        *(u32x4*)((bf16_t*)(big + KBIG_QM) + (size_t)row * 3072 + col) = pack8_bf16(v0, v1);
                    } else {
                        *(u32x4*)((bf16_t*)(big + KBIG_KVM) + (size_t)row * 4096 + col) = pack8_bf16(v0, v1);
                    }
                }
                if (mode == EM_DKV && colt < 1280) {
                    ss = quad16_sum(ss);
                    if (fq == 0) rowss_add((u64*)(ws + KCTL_ROWSS) + (size_t)(colt < 768 ? 9 : 10) * KM + row, ss);
                }
                if (m & 1) asm volatile("" ::: "memory");
            }
    }
};
template <class Epi, class Sched, bool ALIGN_EPI = false, bool SP2 = false>
__device__ __forceinline__ void gemm_phase(PG8_LAS unsigned char* lds, const Gemm g, const Sched& S, const Epi& E) {
    int tid_ = threadIdx.x; asm volatile("" : "+v"(tid_));
    const int tid = tid_, wid = __builtin_amdgcn_readfirstlane(tid >> 6), lane = tid & 63, wr = wid >> 2, wc = wid & 3, fr = lane & 15, fq = lane >> 4;
    const int K = g.K, nt = K / BK;
    unsigned voffA[2], voffB[2];
#pragma unroll
    for (int i = 0; i < 2; ++i) { int R, C; stage_rc(tid * 16 + i * 8192, R, C); const int Rb = Epi::PERM ? ((R & ~31) + perm32(R & 31)) : R;
        voffA[i] = (unsigned)(R * K + C) * 2u; voffB[i] = (unsigned)(Rb * K + C) * 2u; }
    const size_t kstep = (size_t)(BK * 2);
    const size_t hstep = (size_t)HALF * K * 2;
    const size_t tstep = 2 * hstep;
    const unsigned ldsw = (unsigned)wid * 1024u;
    const int aoff = lds_byte(wr * 64 + fr, fq * 8), boff = lds_byte(wc * 32 + fr, fq * 8);
#define PG8_SA(b, h) (((b) * 2 + (h)) * HTB)
#define PG8_SB(b, h) ((4 + (b) * 2 + (h)) * HTB)
#define PG8_STAGE(bufoff, gbase, voff) do { const char* gb_ = (const char*)(gbase); asm volatile("" : "+s"(gb_));     \
        _Pragma("unroll") for (int _i = 0; _i < 2; ++_i) \
        __builtin_amdgcn_global_load_lds((const unsigned*)(gb_ + (voff)[_i]), (PG8_LAS unsigned*)(lds + (bufoff) + ldsw + _i * 8192), 16, 0, 0); } while (0)
#define PG8_VOFF_OPAQUE asm volatile("" : "+v"(voffA[0]), "+v"(voffA[1]), "+v"(voffB[0]), "+v"(voffB[1]))
#define PG8_LDA(dst, b, h) do { _Pragma("unroll") for (int m = 0; m < 4; ++m) _Pragma("unroll") for (int k = 0; k < 2; ++k) dst[m][k] = *(const PG8_LAS bf16x8*)(lds + PG8_SA(b, h) + aoff + m * 2048 + k * 1024); } while (0)
#define PG8_LDB(dst, b, h) do { _Pragma("unroll") for (int n = 0; n < 2; ++n) _Pragma("unroll") for (int k = 0; k < 2; ++k) dst[n][k] = *(const PG8_LAS bf16x8*)(lds + PG8_SB(b, h) + boff + n * 2048 + k * 1024); } while (0)
#define PG8_MMA(ai, bj, At, Bt) do { __builtin_amdgcn_s_setprio(1); _Pragma("unroll") for (int m = 0; m < 4; ++m) _Pragma("unroll") for (int n = 0; n < 2; ++n) _Pragma("unroll") for (int k = 0; k < 2; ++k) \
        acc[ai][bj][m][n] = __builtin_amdgcn_mfma_f32_16x16x32_bf16(Bt[n][k], At[m][k], acc[ai][bj][m][n], 0, 0, 0); __builtin_amdgcn_s_setprio(0); } while (0)
#define PG8_WAIT_V(n) asm volatile("s_waitcnt vmcnt(" #n ")" ::: "memory")
#define PG8_WAIT_L(n) asm volatile("s_waitcnt lgkmcnt(" #n ")" ::: "memory")
#define PG8_BAR __builtin_amdgcn_s_barrier()
#define PG8_SCHED __builtin_amdgcn_sched_barrier(0)
    Unit cur, nxt; int ui = 0;
    if (!S.next(0, cur)) return;
    f32x4 acc[2][2][4][2];
#pragma unroll
    for (int a = 0; a < 2; ++a)
#pragma unroll
        for (int b = 0; b < 2; ++b)
#pragma unroll
            for (int m = 0; m < 4; ++m)
#pragma unroll
                for (int n = 0; n < 2; ++n) acc[a][b][m][n] = (f32x4){0.f, 0.f, 0.f, 0.f};
    bf16x8 At[4][2], B0[2][2], B1[2][2];
    const char* cA = (const char*)g.A + (size_t)cur.pm * tstep; const char* cB = (const char*)g.Bt + (size_t)cur.pn * tstep;
    S.a_ready(cur);
    typename Epi::Pref pf; E.prefetch(cur, wr, fr, pf);
    PG8_VOFF_OPAQUE;
    if constexpr (SP2) {
        PG8_STAGE(PG8_SB(0, 0), cB, voffB); PG8_STAGE(PG8_SB(0, 1), cB + hstep, voffB); PG8_STAGE(PG8_SA(0, 0), cA, voffA); PG8_STAGE(PG8_SA(0, 1), cA + hstep, voffA);
        if (wr == 1) PG8_BAR;
        PG8_WAIT_V(2); PG8_BAR;
        PG8_STAGE(PG8_SB(1, 0), cB + kstep, voffB); PG8_STAGE(PG8_SA(1, 0), cA + kstep, voffA); PG8_STAGE(PG8_SB(1, 1), cB + hstep + kstep, voffB);
        PG8_WAIT_V(6); PG8_BAR;
    } else {
        PG8_STAGE(PG8_SB(0, 0), cB, voffB); PG8_STAGE(PG8_SA(0, 0), cA, voffA); PG8_STAGE(PG8_SB(0, 1), cB + hstep, voffB); PG8_STAGE(PG8_SA(0, 1), cA + hstep, voffA);
        if (wr == 1) PG8_BAR;
        PG8_WAIT_V(4); PG8_BAR;
        PG8_STAGE(PG8_SB(1, 0), cB + kstep, voffB); PG8_STAGE(PG8_SA(1, 0), cA + kstep, voffA); PG8_STAGE(PG8_SB(1, 1), cB + hstep + kstep, voffB);
        PG8_WAIT_V(6); PG8_BAR;
    }
    for (;;) {
        const bool has_next = S.next(ui + 1, nxt);
        const char* nA = has_next ? (const char*)g.A + (size_t)nxt.pm * tstep : cA; const char* nB = has_next ? (const char*)g.Bt + (size_t)nxt.pn * tstep : cB;
        for (int t = 0; t < nt; t += 2) {
            PG8_VOFF_OPAQUE;
            const bool last = (t == nt - 2);
            const char* a1 = cA + (size_t)(t + 1) * kstep;
            const char* a2 = last ? nA : cA + (size_t)(t + 2) * kstep; const char* b2 = last ? nB : cB + (size_t)(t + 2) * kstep;
            const char* a3 = a2 + kstep; const char* b3 = b2 + kstep;
            if (last && has_next) S.a_ready(nxt);
            if constexpr (SP2) {
            PG8_LDB(B0, 0, 0); PG8_LDB(B1, 0, 1); PG8_SCHED; PG8_LDA(At, 0, 0); PG8_STAGE(PG8_SA(1, 1), a1 + hstep, voffA);
            PG8_WAIT_V(8); PG8_WAIT_L(0); PG8_BAR; PG8_MMA(0, 0, At, B0); PG8_MMA(0, 1, At, B1); PG8_BAR; PG8_SCHED;
            PG8_LDA(At, 0, 1); PG8_STAGE(PG8_SB(0, 0), b2, voffB); PG8_STAGE(PG8_SB(0, 1), b2 + hstep, voffB); PG8_STAGE(PG8_SA(0, 0), a2, voffA);
            PG8_WAIT_V(8); PG8_WAIT_L(0); PG8_BAR; PG8_MMA(1, 0, At, B0); PG8_MMA(1, 1, At, B1); PG8_BAR; PG8_SCHED;
            PG8_LDB(B0, 1, 0); PG8_LDB(B1, 1, 1); PG8_SCHED; PG8_LDA(At, 1, 0); PG8_STAGE(PG8_SA(0, 1), a2 + hstep, voffA);
            PG8_WAIT_V(8); PG8_WAIT_L(0); PG8_BAR; PG8_MMA(0, 0, At, B0); PG8_MMA(0, 1, At, B1); PG8_BAR; PG8_SCHED;
            PG8_LDA(At, 1, 1); PG8_STAGE(PG8_SB(1, 0), b3, voffB); PG8_STAGE(PG8_SB(1, 1), b3 + hstep, voffB); PG8_STAGE(PG8_SA(1, 0), a3, voffA);
            PG8_WAIT_V(8); PG8_WAIT_L(0); PG8_BAR; PG8_MMA(1, 0, At, B0); PG8_MMA(1, 1, At, B1); PG8_BAR; PG8_SCHED;
            } else {
            PG8_LDB(B0, 0, 0); PG8_SCHED; PG8_LDA(At, 0, 0); PG8_STAGE(PG8_SA(1, 1), a1 + hstep, voffA);
            PG8_WAIT_L(8); PG8_BAR; PG8_WAIT_L(0); PG8_MMA(0, 0, At, B0); PG8_BAR; PG8_SCHED;
            PG8_LDB(B1, 0, 1); PG8_STAGE(PG8_SB(0, 0), b2, voffB);
            PG8_BAR; PG8_WAIT_L(0); PG8_MMA(0, 1, At, B1); PG8_BAR;
            PG8_LDA(At, 0, 1); PG8_STAGE(PG8_SA(0, 0), a2, voffA);
            PG8_BAR; PG8_WAIT_L(0); PG8_MMA(1, 0, At, B0); PG8_BAR; PG8_SCHED;
            PG8_STAGE(PG8_SB(0, 1), b2 + hstep, voffB);
            PG8_WAIT_V(6); PG8_BAR; PG8_MMA(1, 1, At, B1); PG8_BAR;
            PG8_LDB(B0, 1, 0); PG8_SCHED; PG8_LDA(At, 1, 0); PG8_STAGE(PG8_SA(0, 1), a2 + hstep, voffA);
            PG8_WAIT_L(8); PG8_BAR; PG8_WAIT_L(0); PG8_MMA(0, 0, At, B0); PG8_BAR; PG8_SCHED;
            PG8_LDB(B1, 1, 1); PG8_STAGE(PG8_SB(1, 0), b3, voffB);
            PG8_BAR; PG8_WAIT_L(0); PG8_MMA(0, 1, At, B1); PG8_BAR;
            PG8_LDA(At, 1, 1); PG8_STAGE(PG8_SA(1, 0), a3, voffA);
            PG8_BAR; PG8_WAIT_L(0); PG8_MMA(1, 0, At, B0); PG8_BAR; PG8_SCHED;
            PG8_STAGE(PG8_SB(1, 1), b3 + hstep, voffB);
            PG8_WAIT_V(6); PG8_BAR; PG8_MMA(1, 1, At, B1); PG8_BAR;
            }
        }
        if constexpr (ALIGN_EPI) { if (wr == 0) PG8_BAR; }
        if constexpr (!Epi::AFTER_DRAIN) { E(acc, cur, wr, wc, fr, fq, pf); S.done(cur); }
        if (!has_next) break;
#pragma unroll
        for (int a = 0; a < 2; ++a)
#pragma unroll
            for (int b = 0; b < 2; ++b)
#pragma unroll
                for (int m = 0; m < 4; ++m)
#pragma unroll
                    for (int n = 0; n < 2; ++n) acc[a][b][m][n] = (f32x4){0.f, 0.f, 0.f, 0.f};
        cur = nxt; cA = nA; cB = nB; ++ui;
        E.prefetch(cur, wr, fr, pf);
        if constexpr (ALIGN_EPI) { if (wr == 1) PG8_BAR; }
    }
    PG8_WAIT_V(0);
    if constexpr (!ALIGN_EPI) { if (wr == 0) PG8_BAR; }
    PG8_BAR;
    if constexpr (Epi::AFTER_DRAIN) { E.fused(acc, cur, wr, wc, fr, fq, lds, wid, lane); S.done(cur); }
#undef PG8_SA
#undef PG8_SB
#undef PG8_STAGE
#undef PG8_LDA
#undef PG8_LDB
#undef PG8_MMA
#undef PG8_WAIT_V
#undef PG8_WAIT_L
#undef PG8_BAR
#undef PG8_SCHED
}
}

#define GAS __attribute__((address_space(1)))
#define LAS __attribute__((address_space(3)))
typedef unsigned short bf16;
typedef unsigned v4u __attribute__((ext_vector_type(4)));
typedef unsigned v2u __attribute__((ext_vector_type(2)));
typedef float f32x4 __attribute__((ext_vector_type(4)));
typedef float f32x2 __attribute__((ext_vector_type(2)));
typedef short bf16x8 __attribute__((ext_vector_type(8)));
typedef GAS unsigned gu32;
#define RLX_AGENT __ATOMIC_RELAXED, __HIP_MEMORY_SCOPE_AGENT
#define LDS_WAIT() asm volatile("s_waitcnt lgkmcnt(0)" ::: "memory")
#define VM_WAIT() asm volatile("s_waitcnt vmcnt(0)" ::: "memory")
__device__ __forceinline__ unsigned pk2(float lo, float hi) { unsigned r; asm("v_cvt_pk_bf16_f32 %0, %1, %2" : "=v"(r) : "v"(lo), "v"(hi)); return r; }
__device__ __forceinline__ unsigned f2bf(float f) { return pk2(f, f) & 0xffffu; }
__device__ __forceinline__ float bf2f(unsigned short h) { return __builtin_bit_cast(float, (unsigned)h << 16); }
__device__ __forceinline__ float wave_sum(float v) {
#pragma unroll
    for (int o = 1; o < 64; o <<= 1) v += __shfl_xor(v, o);
    return v;
}
__device__ __forceinline__ float wave_max(float v) {
#pragma unroll
    for (int o = 1; o < 64; o <<= 1) v = fmaxf(v, __shfl_xor(v, o));
    return v;
}
#define XB_TMO      128
#define XB_XCNT(j)  (256  + 64 * (j))
#define XB_XSUB(j)  (1280 + 64 * (j))
#define XB_XGEN(j)  (2304 + 64 * (j))
#define XB_TOP      3328
#define XB_TOPGEN   3392
#define XCD_BAR_WORDS 3456
#define XB_SPIN_CAP (1u << 18)

__device__ __forceinline__ unsigned xb_ld(unsigned* p)              { return __hip_atomic_load(p, __ATOMIC_RELAXED, __HIP_MEMORY_SCOPE_AGENT); }
__device__ __forceinline__ unsigned xb_add(unsigned* p, unsigned v) { return __hip_atomic_fetch_add(p, v, __ATOMIC_RELAXED, __HIP_MEMORY_SCOPE_AGENT); }
__device__ __forceinline__ unsigned xb_xcc_id() { return (unsigned)__builtin_amdgcn_s_getreg((3 << 11) | 20) & 0xFu; }
#define XB_SPIN(cond, bar) do { unsigned _sp = 0; while (cond) { __builtin_amdgcn_s_sleep(1); \
    if ((++_sp & 255u) == 0u) { if (xb_ld(&(bar)[XB_TMO])) break; if (_sp > XB_SPIN_CAP) { atomicAdd(&(bar)[XB_TMO], 1u); break; } } } } while (0)

struct XcdBarrier {
    unsigned* bar; unsigned x;
    volatile LAS unsigned* st;
};

__device__ __forceinline__ XcdBarrier xcd_barrier_post(unsigned* bar, volatile LAS unsigned* st) {
    XcdBarrier b; b.bar = bar; b.x = xb_xcc_id(); b.st = st;
    if (threadIdx.x == 0) (void)xb_add(&bar[XB_XCNT(b.x)], 1u);
    return b;
}
__device__ __forceinline__ void xcd_barrier_complete(unsigned* bar, unsigned x, unsigned& nloc, unsigned& nx) {
    const unsigned G = gridDim.x * gridDim.y * gridDim.z;
    unsigned sum, cnt, mine, sp = 0u;
    for (;;) {
        sum = 0u; cnt = 0u; mine = 0u;
#pragma unroll
        for (unsigned j = 0; j < 16; ++j) { const unsigned c = xb_ld(&bar[XB_XCNT(j)]); sum += c; cnt += (c > 0u) ? 1u : 0u; mine = (j == x) ? c : mine; }
        if (sum == G) break;
        __builtin_amdgcn_s_sleep(1);
        if ((++sp & 255u) == 0u) { if (xb_ld(&bar[XB_TMO])) break; if (sp > XB_SPIN_CAP) { atomicAdd(&bar[XB_TMO], 1u); break; } }
    }
    nloc = mine > 0u ? mine : 1u; nx = cnt > 0u ? cnt : 1u;
}

__device__ __forceinline__ void xcd_barrier(const XcdBarrier& b) {
    asm volatile("s_waitcnt vmcnt(0)" ::: "memory");
    __syncthreads();
    if (threadIdx.x == 0) {
        unsigned* bar = b.bar;
        __builtin_amdgcn_s_waitcnt(0);
        unsigned nloc = b.st[0], nx = b.st[1];
        if (nloc == 0u) { xcd_barrier_complete(bar, b.x, nloc, nx); b.st[0] = nloc; b.st[1] = nx; }
        const unsigned old = xb_add(&bar[XB_XSUB(b.x)], 1u);
        const unsigned gen = old / nloc;
        if (old + 1u == (gen + 1u) * nloc) {
            __builtin_amdgcn_fence(__ATOMIC_RELEASE, "agent");
            asm volatile("s_waitcnt vmcnt(0)" ::: "memory");
            const unsigned og = xb_add(&bar[XB_TOP], 1u);
            const unsigned tg = og / nx;
            if (og + 1u == (tg + 1u) * nx) xb_add(&bar[XB_TOPGEN], 1u);
            else XB_SPIN(xb_ld(&bar[XB_TOPGEN]) == tg, bar);
            __builtin_amdgcn_fence(__ATOMIC_ACQUIRE, "agent");
            xb_add(&bar[XB_XGEN(b.x)], 1u);
            asm volatile("s_waitcnt vmcnt(0)" ::: "memory");
        } else {
            XB_SPIN(xb_ld(&bar[XB_XGEN(b.x)]) == gen, bar);
            __builtin_amdgcn_fence(__ATOMIC_ACQUIRE, "agent");
            asm volatile("s_waitcnt vmcnt(0)" ::: "memory");
        }
    }
    __syncthreads();
}

namespace att {
typedef float f32x16 __attribute__((ext_vector_type(16)));
typedef short s16x4 __attribute__((ext_vector_type(4)));
constexpr float SB_DONE = 281474976710656.0f;
constexpr int SHM_K = 64 * 128 * 2, SHM_V = 64 * 128 * 2, SHM_P = 64 * 64 * 2;
#define KSWZ(row, colB) ((row) * 256 + ((colB) ^ (((row) & 7) << 4)))
#define PSWZ(row, colB) ((row) * 128 + ((colB) ^ ((((row) >> 1) & 7) << 4)))
#define SBAR() __builtin_amdgcn_sched_barrier(0)
__device__ __forceinline__ int v_st(int k, int c) { const int kk = (k & ~0xC) | ((k & 4) << 1) | ((k & 8) >> 1); return ((kk >> 3) * 4 + (c >> 5)) * 512 + ((kk & 7) * 32 + (c & 31)) * 2; }
__device__ __forceinline__ int v_rd_base(int lane) { return ((lane & 3) << 3) | (((lane >> 2) & 3) << 6) | (((lane >> 4) & 1) << 5) | (((lane >> 5) & 1) << 8); }
__device__ __forceinline__ unsigned cvtpk(float lo, float hi) { unsigned r; asm volatile("v_cvt_pk_bf16_f32 %0, %1, %2" : "=v"(r) : "v"(lo), "v"(hi)); return r; }
#define PK4(P, B_, OUT) do { unsigned a0 = cvtpk(P[B_+0], P[B_+1]), a1 = cvtpk(P[B_+2], P[B_+3]), b0 = cvtpk(P[B_+4], P[B_+5]), b1 = cvtpk(P[B_+6], P[B_+7]); \
        auto r0 = __builtin_amdgcn_permlane32_swap(a0, b0, false, false); auto r1 = __builtin_amdgcn_permlane32_swap(a1, b1, false, false); \
        v4u w = {r0[0], r1[0], r0[1], r1[1]}; OUT = __builtin_bit_cast(bf16x8, w); } while (0)
__device__ __forceinline__ void qkt128(f32x16& p0, f32x16& p1, const LAS unsigned char* Kt, int r32, int hi, const bf16x8* qr) {
    const LAS unsigned char* kb[4];
#pragma unroll
    for (int dd = 0; dd < 4; ++dd) kb[dd] = Kt + KSWZ(r32, (dd * 16 + hi * 8) * 2);
#pragma unroll
    for (int d0 = 0; d0 < 8; ++d0) { const LAS unsigned char* a = kb[d0 & 3] + (d0 >> 2) * 128;
        const bf16x8 b0 = *(const LAS bf16x8*)a, b1 = *(const LAS bf16x8*)(a + 32 * 256);
        p0 = __builtin_amdgcn_mfma_f32_32x32x16_bf16(b0, qr[d0], p0, 0, 0, 0);
        p1 = __builtin_amdgcn_mfma_f32_32x32x16_bf16(b1, qr[d0], p1, 0, 0, 0); }
}
__device__ __forceinline__ void pv_tile(f32x16* o, int vb, bf16x8 pa0, bf16x8 pa1, bf16x8 pa2, bf16x8 pa3) {
#define TRRD(dst, off) asm volatile("ds_read_b64_tr_b16 %0, %1 offset:%2" : "=&v"(dst) : "v"(vb), "i"(off) : "memory")
#define PV_RD(S, d0) do { constexpr int b_ = (d0) * 512; TRRD(S##l0, b_); TRRD(S##h0, b_ + 2048); TRRD(S##l1, b_ + 4096); TRRD(S##h1, b_ + 6144); TRRD(S##l2, b_ + 8192); TRRD(S##h2, b_ + 10240); TRRD(S##l3, b_ + 12288); TRRD(S##h3, b_ + 14336); } while (0)
#define PV_MM(S, d0) do { \
        o[d0] = __builtin_amdgcn_mfma_f32_32x32x16_bf16((bf16x8){S##l0[0], S##l0[1], S##l0[2], S##l0[3], S##h0[0], S##h0[1], S##h0[2], S##h0[3]}, pa0, o[d0], 0, 0, 0); \
        o[d0] = __builtin_amdgcn_mfma_f32_32x32x16_bf16((bf16x8){S##l1[0], S##l1[1], S##l1[2], S##l1[3], S##h1[0], S##h1[1], S##h1[2], S##h1[3]}, pa1, o[d0], 0, 0, 0); \
        o[d0] = __builtin_amdgcn_mfma_f32_32x32x16_bf16((bf16x8){S##l2[0], S##l2[1], S##l2[2], S##l2[3], S##h2[0], S##h2[1], S##h2[2], S##h2[3]}, pa2, o[d0], 0, 0, 0); \
        o[d0] = __builtin_amdgcn_mfma_f32_32x32x16_bf16((bf16x8){S##l3[0], S##l3[1], S##l3[2], S##l3[3], S##h3[0], S##h3[1], S##h3[2], S##h3[3]}, pa3, o[d0], 0, 0, 0); } while (0)
    s16x4 Al0, Al1, Al2, Al3, Ah0, Ah1, Ah2, Ah3, Bl0, Bl1, Bl2, Bl3, Bh0, Bh1, Bh2, Bh3;
    PV_RD(A, 0); PV_RD(B, 1);
    asm volatile("s_waitcnt lgkmcnt(8)" ::: "memory"); SBAR(); PV_MM(A, 0); SBAR();
    PV_RD(A, 2);
    asm volatile("s_waitcnt lgkmcnt(8)" ::: "memory"); SBAR(); PV_MM(B, 1); SBAR();
    PV_RD(B, 3);
    asm volatile("s_waitcnt lgkmcnt(8)" ::: "memory"); SBAR(); PV_MM(A, 2); SBAR();
    asm volatile("s_waitcnt lgkmcnt(0)" ::: "memory"); SBAR(); PV_MM(B, 3);
#undef PV_RD
#undef PV_MM
#undef TRRD
}
typedef __bf16 bf16x2_t __attribute__((ext_vector_type(2)));
__device__ __forceinline__ unsigned cvtpk_c(float a, float b) { const f32x2 f = {a, b}; return __builtin_bit_cast(unsigned, __builtin_convertvector(f, bf16x2_t)); }
__device__ __forceinline__ void store_o(const f32x16* o, bf16* Ow  , int r32, int hi, float scale) {
    bf16* row = Ow + (size_t)r32 * 2048 + hi * 8;
#pragma unroll
    for (int d0 = 0; d0 < 4; ++d0) {
#pragma unroll
        for (int b8 = 0; b8 < 16; b8 += 8) {
            const unsigned a0 = cvtpk_c(o[d0][b8 + 0] * scale, o[d0][b8 + 1] * scale), a1 = cvtpk_c(o[d0][b8 + 2] * scale, o[d0][b8 + 3] * scale);
            const unsigned b0 = cvtpk_c(o[d0][b8 + 4] * scale, o[d0][b8 + 5] * scale), b1 = cvtpk_c(o[d0][b8 + 6] * scale, o[d0][b8 + 7] * scale);
            auto r0 = __builtin_amdgcn_permlane32_swap(a0, b0, false, false); auto r1 = __builtin_amdgcn_permlane32_swap(a1, b1, false, false);
            *(v4u*)(row + d0 * 32 + 2 * b8) = (v4u){r0[0], r1[0], r0[1], r1[1]}; } }
}

__device__ __forceinline__ void sb_unit(const bf16* __restrict__ qkv, bf16* __restrict__ ob, int b, int h, int qb, LAS unsigned char* lds) {
    int tid_ = threadIdx.x; asm volatile("" : "+v"(tid_));
    const int tid = tid_, wid = __builtin_amdgcn_readfirstlane(tid >> 6), lane = tid & 63, r32 = lane & 31, hi = lane >> 5;
    const size_t rowbase = (size_t)b * SEQ; const int q0 = qb * 256;
    const bf16* Kg = qkv + rowbase * 6144 + 2048 + h * 128; const bf16* Vg = qkv + rowbase * 6144 + 4096 + h * 128;
    LAS unsigned char* V_lds = lds; LAS unsigned char* K_lds = lds + 2 * SHM_V;
    const int sr = tid >> 4, sc = (tid & 15) * 8, vst0 = v_st(sr, sc), vst1 = v_st(32 + sr, sc), kws = KSWZ(sr, sc * 2);
    const int vb0 = (int)(unsigned)(uintptr_t)V_lds + v_rd_base(lane);
    bf16x8 qr[8];
    { const bf16* Qw = qkv + (rowbase + q0 + wid * 32 + r32) * 6144 + h * 128;
#pragma unroll
      for (int d0 = 0; d0 < 8; ++d0) qr[d0] = *(const bf16x8*)(Qw + d0 * 16 + hi * 8); }
    const int NT = 4 * qb + 4;
    const int jmax = 4 * qb + (wid >> 1);
    const int qrow = q0 + wid * 32 + r32;
    f32x16 o[4]; o[0] = f32x16{}; o[1] = f32x16{}; o[2] = f32x16{}; o[3] = f32x16{};
    float run = 1.0f;
    bf16x8 st_k0, st_k1, st_v0, st_v1;
#define SLOAD(jt) do { const size_t k0_ = (size_t)(jt) * 64; st_v0 = *(const bf16x8*)(Vg + (k0_ + sr) * 6144 + sc); st_v1 = *(const bf16x8*)(Vg + (k0_ + 32 + sr) * 6144 + sc); \
                       st_k0 = *(const bf16x8*)(Kg + (k0_ + sr) * 6144 + sc); st_k1 = *(const bf16x8*)(Kg + (k0_ + 32 + sr) * 6144 + sc); } while (0)
#define SWRITE(bf) do { *(LAS bf16x8*)(V_lds + (bf) * SHM_V + vst0) = st_v0; *(LAS bf16x8*)(V_lds + (bf) * SHM_V + vst1) = st_v1; \
                        *(LAS bf16x8*)(K_lds + (bf) * SHM_K + kws) = st_k0; *(LAS bf16x8*)(K_lds + (bf) * SHM_K + kws + 32 * 256) = st_k1; } while (0)
    SLOAD(NT - 1); VM_WAIT(); SWRITE(0); if (NT > 1) SLOAD(NT - 2);
    __syncthreads();
    bool wdone = false;
    for (int i = 0; i < NT; ++i) {
        const int jt = NT - 1 - i, bf = i & 1;
        if (jt <= jmax && !wdone) {
            f32x16 p0 = f32x16{}, p1 = f32x16{}, u0, u1;
            qkt128(p0, p1, K_lds + bf * SHM_K, r32, hi, qr);
            const int dq = qrow - jt * 64 - 4 * hi;
            const bool need_mask = (jt * 64 + 63 >= q0 + wid * 32);
#define SB_EU(MASKED) do { _Pragma("unroll") for (int r = 0; r < 16; ++r) { const int c = (r & 3) + 8 * (r >> 2); \
                { float E = __builtin_amdgcn_exp2f(fminf(p0[r], 64.f)); float u = 1.0f + E; if (MASKED && !(c < dq)) { E = 0.f; u = 1.0f; } p0[r] = E; u0[r] = u; } \
                { float E = __builtin_amdgcn_exp2f(fminf(p1[r], 64.f)); float u = 1.0f + E; if (MASKED && !(c + 32 < dq)) { E = 0.f; u = 1.0f; } p1[r] = E; u1[r] = u; } } } while (0)
            if (need_mask) SB_EU(true); else SB_EU(false);
#undef SB_EU
            float Ip[9], oth[9];
#pragma unroll
            for (int j = 0; j < 4; ++j) { u0[4 * j + 2] *= u0[4 * j + 3]; u0[4 * j + 1] *= u0[4 * j + 2]; u0[4 * j] *= u0[4 * j + 1];
                                          u1[4 * j + 2] *= u1[4 * j + 3]; u1[4 * j + 1] *= u1[4 * j + 2]; u1[4 * j] *= u1[4 * j + 1]; }
            Ip[8] = 1.0f; Ip[7] = u1[12];
#pragma unroll
            for (int j = 6; j >= 0; --j) Ip[j] = Ip[j + 1] * ((j < 4) ? u0[4 * j] : u1[4 * (j - 4)]);
#pragma unroll
            for (int j = 0; j < 8; ++j) { auto rr = __builtin_amdgcn_permlane32_swap(__float_as_uint(Ip[j]), __float_as_uint(Ip[j + 1]), false, false); oth[j] = __uint_as_float(hi ? rr[0] : rr[1]); }
            { auto rr = __builtin_amdgcn_permlane32_swap(__float_as_uint(Ip[0]), __float_as_uint(Ip[0]), false, false); oth[8] = __uint_as_float(hi ? rr[0] : rr[1]); }
#pragma unroll
            for (int j = 0; j < 8; ++j) {
                const float T = (Ip[j + 1] * oth[j]) * run;
#pragma unroll
                for (int e = 0; e < 4; ++e) {
                    if (j < 4) p0[4 * j + e] *= __builtin_amdgcn_rcpf(u0[4 * j + e] * T);
                    else       p1[4 * (j - 4) + e] *= __builtin_amdgcn_rcpf(u1[4 * (j - 4) + e] * T); }
            }
            run *= Ip[0] * oth[8];
            bf16x8 pa0, pa1, pa2, pa3;
            PK4(p0, 0, pa0); PK4(p0, 8, pa1); PK4(p1, 0, pa2); PK4(p1, 8, pa3);
            SBAR();
            pv_tile(o, vb0 + bf * SHM_V, pa0, pa1, pa2, pa3);
        }
        if (i + 1 < NT) { VM_WAIT(); SWRITE((i + 1) & 1); if (i + 2 < NT) SLOAD(NT - 3 - i); }
        { LAS unsigned* fl = (LAS unsigned*)(lds + 2 * SHM_V + 2 * SHM_K) + (i & 1) * 8;
          wdone = __all(run >= SB_DONE);
          if (lane == 0) fl[wid] = wdone ? 1u : 0u;
          __syncthreads();
          const v4u f0 = *(const LAS v4u*)fl, f1 = *(const LAS v4u*)(fl + 4);
          if ((f0.x & f0.y & f0.z & f0.w & f1.x & f1.y & f1.z & f1.w) != 0u) break; }
    }
#undef SLOAD
#undef SWRITE
    store_o(o, ob + (rowbase + q0 + wid * 32) * 2048 + h * 128, r32, hi, 1.0f);
}
__device__ __forceinline__ void sb_phase(const bf16* qkv, bf16* ob, LAS unsigned char* lds, int vcu, int G) {
    for (int item = vcu; item < BATCH * NH * 16; item += G) {
        const int bh = item >> 4, x = item & 15;
        sb_unit(qkv, ob, bh / NH, bh % NH, 31 - x, lds);
        sb_unit(qkv, ob, bh / NH, bh % NH, x, lds);
    }
}

__device__ __forceinline__ void mla_unit(const bf16* __restrict__ qm, const bf16* __restrict__ kvm, const bf16* __restrict__ kpe, bf16* __restrict__ ob, int b, int h, int qb, LAS unsigned char* lds) {
    int tid_ = threadIdx.x; asm volatile("" : "+v"(tid_));
    const int tid = tid_, wid = __builtin_amdgcn_readfirstlane(tid >> 6), lane = tid & 63, r32 = lane & 31, hi = lane >> 5;
    const size_t rowbase = (size_t)b * SEQ; const int q0 = qb * 256;
    const bf16* Kg = kvm + rowbase * 4096 + h * 256; const bf16* Vg = Kg + 128; const bf16* Pg = kpe + rowbase * 64;
    LAS unsigned char* V_lds = lds; LAS unsigned char* K_lds = lds + 2 * SHM_V; LAS unsigned char* P_lds = lds + 2 * SHM_V + 2 * SHM_K;
    (void)0;
    const int sr = tid >> 4, sc = (tid & 15) * 8, vst0 = v_st(sr, sc), vst1 = v_st(32 + sr, sc), kws = KSWZ(sr, sc * 2);
    const int pr = tid >> 3, pc = (tid & 7) * 8, pws = PSWZ(pr, pc * 2);
    const int vb0 = (int)(unsigned)(uintptr_t)V_lds + v_rd_base(lane);
    bf16x8 qr[12];
    { const bf16* Qw = qm + (rowbase + q0 + wid * 32 + r32) * 3072 + h * 192;
#pragma unroll
      for (int d0 = 0; d0 < 12; ++d0) qr[d0] = *(const bf16x8*)(Qw + d0 * 16 + hi * 8); }
    const int NT = 4 * qb + 4, jmax = 4 * qb + (wid >> 1);
    f32x16 o[4]; o[0] = f32x16{}; o[1] = f32x16{}; o[2] = f32x16{}; o[3] = f32x16{};
    float m_reg = -1e30f, l_reg = 0.f;
    bf16x8 sa_k0, sa_k1, sa_v0, sa_v1, sa_p, sb_k0, sb_k1, sb_v0, sb_v1, sb_p;
#define SLOAD(S, jt) do { const size_t k0_ = (size_t)(jt) * 64; S##_v0 = *(const bf16x8*)(Vg + (k0_ + sr) * 4096 + sc); S##_v1 = *(const bf16x8*)(Vg + (k0_ + 32 + sr) * 4096 + sc); \
                          S##_k0 = *(const bf16x8*)(Kg + (k0_ + sr) * 4096 + sc); S##_k1 = *(const bf16x8*)(Kg + (k0_ + 32 + sr) * 4096 + sc); S##_p = *(const bf16x8*)(Pg + (k0_ + pr) * 64 + pc); } while (0)
#define SWRITE(S, bf) do { *(LAS bf16x8*)(V_lds + (bf) * SHM_V + vst0) = S##_v0; *(LAS bf16x8*)(V_lds + (bf) * SHM_V + vst1) = S##_v1; \
                           *(LAS bf16x8*)(K_lds + (bf) * SHM_K + kws) = S##_k0; *(LAS bf16x8*)(K_lds + (bf) * SHM_K + kws + 32 * 256) = S##_k1; *(LAS bf16x8*)(P_lds + (bf) * SHM_P + pws) = S##_p; } while (0)
    SLOAD(sa, 0); SLOAD(sb, 1); SWRITE(sa, 0); SLOAD(sa, 2);
    __syncthreads();
    auto tile = [&](const int jt, const int bf) __attribute__((always_inline)) {
        if (jt <= jmax) {
            f32x16 p0 = f32x16{}, p1 = f32x16{};
            qkt128(p0, p1, K_lds + bf * SHM_K, r32, hi, qr);
            { const LAS unsigned char* Pt = P_lds + bf * SHM_P;
#pragma unroll
              for (int dd = 0; dd < 4; ++dd) { const LAS unsigned char* a = Pt + PSWZ(r32, (dd * 16 + hi * 8) * 2);
                  const bf16x8 b0 = *(const LAS bf16x8*)a, b1 = *(const LAS bf16x8*)(a + 32 * 128);
                  p0 = __builtin_amdgcn_mfma_f32_32x32x16_bf16(b0, qr[8 + dd], p0, 0, 0, 0);
                  p1 = __builtin_amdgcn_mfma_f32_32x32x16_bf16(b1, qr[8 + dd], p1, 0, 0, 0); } }
            float pmax = p0[0];
#pragma unroll
            for (int r = 1; r < 16; ++r) pmax = fmaxf(pmax, p0[r]);
#pragma unroll
            for (int r = 0; r < 16; ++r) pmax = fmaxf(pmax, p1[r]);
            { auto rr = __builtin_amdgcn_permlane32_swap(__float_as_uint(pmax), __float_as_uint(pmax), false, false); pmax = fmaxf(__uint_as_float(rr[0]), __uint_as_float(rr[1])); }
            const float mn = fmaxf(m_reg, pmax); const float alpha = __builtin_amdgcn_exp2f(m_reg - mn); m_reg = mn;
            float ps = 0.f;
#pragma unroll
            for (int r = 0; r < 16; ++r) { p0[r] = __builtin_amdgcn_exp2f(p0[r] - mn); p1[r] = __builtin_amdgcn_exp2f(p1[r] - mn); ps += p0[r] + p1[r]; }
            { auto rr = __builtin_amdgcn_permlane32_swap(__float_as_uint(ps), __float_as_uint(ps), false, false); ps = __uint_as_float(rr[0]) + __uint_as_float(rr[1]); }
            l_reg = l_reg * alpha + ps;
            if (__any(alpha < 1.f)) {
#pragma unroll
                for (int d0 = 0; d0 < 4; ++d0) o[d0] = o[d0] * alpha;
            }
            bf16x8 pa0, pa1, pa2, pa3;
            PK4(p0, 0, pa0); PK4(p0, 8, pa1); PK4(p1, 0, pa2); PK4(p1, 8, pa3);
            SBAR();
            pv_tile(o, vb0 + bf * SHM_V, pa0, pa1, pa2, pa3);
        }
    };
    for (int jt = 0; jt < NT; jt += 2) {
        tile(jt, 0);
        SWRITE(sb, 1); if (jt + 3 < NT) SLOAD(sb, jt + 3);
        __syncthreads();
        tile(jt + 1, 1);
        if (jt + 2 < NT) { SWRITE(sa, 0); if (jt + 4 < NT) SLOAD(sa, jt + 4); }
        __syncthreads();
    }
#undef SLOAD
#undef SWRITE
    store_o(o, ob + (rowbase + q0 + wid * 32) * 2048 + h * 128, r32, hi, 1.0f / l_reg);
}
__device__ __forceinline__ void mla_phase(const bf16* qm, const bf16* kvm, const bf16* kpe, bf16* ob, LAS unsigned char* lds, int vcu, int G) {
    for (int item = vcu; item < BATCH * NH * 16; item += G) {
        const int bh = item >> 4, x = item & 15;
        mla_unit(qm, kvm, kpe, ob, bh / NH, bh % NH, 31 - x, lds);
        mla_unit(qm, kvm, kpe, ob, bh / NH, bh % NH, x, lds);
    }
}
#undef KSWZ
#undef PSWZ
#undef SBAR
#undef PK4
}

namespace hg {
using att::f32x16; using att::s16x4;
#define KSWZ(row, colB) ((row) * 256 + ((colB) ^ (((row) & 7) << 4)))
#define TRRD(dst, base, off) asm volatile("ds_read_b64_tr_b16 %0, %1 offset:%2" : "=&v"(dst) : "v"(base), "i"(off) : "memory")
#define FRAG(dst, base, ks) do { s16x4 lo_, hi_; TRRD(lo_, base, (ks) * 4096); TRRD(hi_, base, (ks) * 4096 + 2048); asm volatile("s_waitcnt lgkmcnt(0)" ::: "memory"); __builtin_amdgcn_sched_barrier(0);   \
        dst = (bf16x8){lo_[0], lo_[1], lo_[2], lo_[3], hi_[0], hi_[1], hi_[2], hi_[3]}; } while (0)
typedef __bf16 bf16x2_t __attribute__((ext_vector_type(2)));
__device__ __forceinline__ unsigned cvtpk_c(float a, float b) { const f32x2 f = {a, b}; return __builtin_bit_cast(unsigned, __builtin_convertvector(f, bf16x2_t)); }
__device__ __forceinline__ int crow(int r, int hi) { return (r & 3) + 8 * (r >> 2) + 4 * hi; }
__device__ __forceinline__ void st_bf16(LAS unsigned char* p, float v) { *(LAS unsigned short*)p = (unsigned short)f2bf(v); }

__device__ __forceinline__ void pass_a(const bf16* __restrict__ ib, const float* __restrict__ lf, bf16* __restrict__ kvs, float* __restrict__ dec, LAS unsigned char* lds, int vcu, int G) {
    int tid_ = threadIdx.x; asm volatile("" : "+v"(tid_));
    const int tid = tid_, wid = __builtin_amdgcn_readfirstlane(tid >> 6), lane = tid & 63, r32 = lane & 31, hi = lane >> 5;
    LAS unsigned char* Kh = lds; LAS unsigned char* Vt = lds + 16384; LAS float* tot = (LAS float*)(lds + 32768);
    const int sr = tid >> 4, sc = (tid & 15) * 8;
    const int c4 = (tid & 31) * 4, rg = tid >> 5, rg0 = 2 * wid;
    const int vblk = wid >> 1, cblk0 = 2 * (wid & 1);
    const int vbV = (int)(unsigned)(uintptr_t)Vt + att::v_rd_base(lane) + vblk * 512, vbK = (int)(unsigned)(uintptr_t)Kh + att::v_rd_base(lane) + cblk0 * 512;
    bf16x8 st_v0, st_v1; f32x4 lw[4];
#define A_LOAD(U) do { const int bh_ = (U) >> 7, n_ = (U) & 127; const size_t r0_ = (size_t)(bh_ >> 4) * SEQ + (size_t)n_ * 64; const int h_ = bh_ & 15; \
        st_v0 = *(const bf16x8*)(ib + (r0_ + sr) * 2048 + h_ * 128 + sc); st_v1 = *(const bf16x8*)(ib + (r0_ + 32 + sr) * 2048 + h_ * 128 + sc); \
        _Pragma("unroll") for (int j = 0; j < 4; ++j) lw[j] = *(const f32x4*)(lf + (r0_ + 4 * rg + j) * 2048 + h_ * 128 + c4); } while (0)
    if (vcu < BATCH * NH * NCHUNK) A_LOAD(vcu);
    for (int unit = vcu; unit < BATCH * NH * NCHUNK; unit += G) {
        f32x4 bb[4];
        bb[0] = lw[0]; bb[1] = bb[0] + lw[1]; bb[2] = bb[1] + lw[2]; bb[3] = bb[2] + lw[3];
        *(LAS f32x4*)(tot + rg * 128 + c4) = bb[3];
        *(LAS bf16x8*)(Vt + att::v_st(sr, sc)) = st_v0; *(LAS bf16x8*)(Vt + att::v_st(32 + sr, sc)) = st_v1;
        __syncthreads();
        f32x4 offs = (f32x4){0.f, 0.f, 0.f, 0.f};
        for (int g = 0; g < rg0; ++g) offs = offs + *(const LAS f32x4*)(tot + g * 128 + c4);
        f32x4 blast = offs;
        { const f32x4 own0 = *(const LAS f32x4*)(tot + rg0 * 128 + c4); blast = blast + own0; if (rg != rg0) offs = offs + own0; }
        for (int g = rg0 + 1; g < 16; ++g) blast = blast + *(const LAS f32x4*)(tot + g * 128 + c4);
#pragma unroll
        for (int j = 0; j < 4; ++j) { const f32x4 bf = bb[j] + offs; float kh[4];
#pragma unroll
            for (int e = 0; e < 4; ++e) kh[e] = (1.0f - __expf(lw[j][e])) * __expf(blast[e] - bf[e]);
            v2u w; w.x = pk2(kh[0], kh[1]); w.y = pk2(kh[2], kh[3]);
            *(LAS v2u*)(Kh + att::v_st(4 * rg + j, c4)) = w; }
        if (unit + G < BATCH * NH * NCHUNK) A_LOAD(unit + G);
        if (rg == 0) { f32x4 d4; d4[0] = __expf(blast[0]); d4[1] = __expf(blast[1]); d4[2] = __expf(blast[2]); d4[3] = __expf(blast[3]); *(f32x4*)(dec + (size_t)unit * 128 + c4) = d4; }
        __syncthreads();
        f32x16 a0 = f32x16{}, a1 = f32x16{};
#pragma unroll
        for (int ks = 0; ks < 4; ++ks) { bf16x8 fa, fb0, fb1; FRAG(fa, vbV, ks); FRAG(fb0, vbK, ks); { const int vbK1 = vbK + 512; FRAG(fb1, vbK1, ks); }
            a0 = __builtin_amdgcn_mfma_f32_32x32x16_bf16(fb0, fa, a0, 0, 0, 0); a1 = __builtin_amdgcn_mfma_f32_32x32x16_bf16(fb1, fa, a1, 0, 0, 0); }
        bf16* dst = kvs + (size_t)unit * 16384 + (size_t)(vblk * 32 + r32) * 128 + cblk0 * 32 + hi * 8;
#define A_PK4(P, B_, OUT) do { unsigned a0_ = cvtpk_c(P[B_+0], P[B_+1]), a1_ = cvtpk_c(P[B_+2], P[B_+3]), b0_ = cvtpk_c(P[B_+4], P[B_+5]), b1_ = cvtpk_c(P[B_+6], P[B_+7]); \
        auto r0_ = __builtin_amdgcn_permlane32_swap(a0_, b0_, false, false); auto r1_ = __builtin_amdgcn_permlane32_swap(a1_, b1_, false, false); \
        OUT = (v4u){r0_[0], r1_[0], r0_[1], r1_[1]}; } while (0)
        { v4u w0, w1, w2, w3; A_PK4(a0, 0, w0); A_PK4(a0, 8, w1); A_PK4(a1, 0, w2); A_PK4(a1, 8, w3);
          *(v4u*)(dst) = w0; *(v4u*)(dst + 16) = w1; *(v4u*)(dst + 32) = w2; *(v4u*)(dst + 48) = w3; }
#undef A_PK4
        __syncthreads();
    }
#undef A_LOAD
}
__device__ __forceinline__ void pass_b(bf16* __restrict__ kvs, const float* __restrict__ dec, LAS unsigned char* lds, int vcu, int G) {
    int tid_ = threadIdx.x; asm volatile("" : "+v"(tid_));
    LAS float* dl = (LAS float*)lds;
    for (int idx = vcu * 512 + tid_; idx < BATCH * NH * 8192; idx += G * 512) {
        const int bh = idx >> 13, rem = idx & 8191, v = rem >> 6, cp = rem & 63;
        unsigned* p = (unsigned*)(kvs + (size_t)bh * 128 * 16384 + v * 128 + 2 * cp);
        __syncthreads();
        { const float* dsrc = dec + (size_t)bh * 128 * 128;
#pragma unroll
          for (int j = 0; j < 8; ++j) *(LAS f32x4*)(dl + (tid_ + 512 * j) * 4) = *(const f32x4*)(dsrc + (tid_ + 512 * j) * 4); }
        __syncthreads();
        const LAS float* dq = dl + 2 * cp;
        float S0 = 0.f, S1 = 0.f;
        unsigned la[32], lb[32];
#define B_LOAD(L, N0) do { _Pragma("unroll") for (int k = 0; k < 32; ++k) L[k] = p[(size_t)((N0) + k) * 8192]; } while (0)
#define B_STEP(L, N0) do { _Pragma("unroll") for (int k = 0; k < 32; ++k) { const f32x2 dd = *(const LAS f32x2*)(dq + ((N0) + k) * 128); p[(size_t)((N0) + k) * 8192] = pk2(S0, S1); \
                S0 = dd.x * S0 + __builtin_bit_cast(float, L[k] << 16); S1 = dd.y * S1 + __builtin_bit_cast(float, L[k] & 0xffff0000u); } } while (0)
        B_LOAD(la, 0);
        for (int n0 = 0; n0 < NCHUNK; n0 += 64) {
            B_LOAD(lb, n0 + 32);
            B_STEP(la, n0);
            if (n0 + 64 < NCHUNK) B_LOAD(la, n0 + 64);
            B_STEP(lb, n0 + 32);
        }
#undef B_LOAD
#undef B_STEP
    }
}
__device__ __forceinline__ void pass_c(const bf16* __restrict__ qb, const bf16* __restrict__ ib, const bf16* __restrict__ gb, const float* __restrict__ lf, const bf16* __restrict__ kvs,
                                       const float* __restrict__ gnorm, bf16* __restrict__ ob, LAS unsigned char* lds, int vcu, int G) {
    int tid_ = threadIdx.x; asm volatile("" : "+v"(tid_));
    const int tid = tid_, wid = __builtin_amdgcn_readfirstlane(tid >> 6), lane = tid & 63, r32 = lane & 31, hi = lane >> 5;
    LAS unsigned char* Kt = lds; LAS unsigned char* Vt = lds + 16384; LAS unsigned char* Qt = lds + 32768; LAS unsigned char* Qi = lds + 49152;
    LAS float* tot = (LAS float*)(lds + 65536); LAS float* sst = (LAS float*)(lds + 73728);
    const int sr = tid >> 4, sc = (tid & 15) * 8;
    const int c4 = (tid & 31) * 4, rg = tid >> 5, rg0 = 2 * wid;
    const int tb = wid & 1, vblk = wid >> 1;
    const int vbV = (int)(unsigned)(uintptr_t)Vt + att::v_rd_base(lane) + vblk * 512;
    bf16x8 st_v0, st_v1; v2u g0[4], ng0[4]; f32x4 lw[4]; v2u qw[4];
    f32x4 gn[4];
#pragma unroll
    for (int g = 0; g < 4; ++g) gn[g] = *(const f32x4*)(gnorm + 32 * vblk + 8 * g + 4 * hi);
#define C_LOAD(U, G0) do { const int bh_ = (U) >> 7, n_ = (U) & 127; const size_t r0_ = (size_t)(bh_ >> 4) * SEQ + (size_t)n_ * 64; const int h_ = bh_ & 15; \
        st_v0 = *(const bf16x8*)(ib + (r0_ + sr) * 2048 + h_ * 128 + sc); st_v1 = *(const bf16x8*)(ib + (r0_ + 32 + sr) * 2048 + h_ * 128 + sc); \
        _Pragma("unroll") for (int j = 0; j < 4; ++j) { const size_t e_ = (r0_ + 4 * rg + j) * 2048 + h_ * 128 + c4; lw[j] = *(const f32x4*)(lf + e_); qw[j] = *(const v2u*)(qb + e_); } \
        { const size_t e_ = (r0_ + tb * 32 + r32) * 2048 + h_ * 128 + 32 * vblk + 4 * hi; _Pragma("unroll") for (int g = 0; g < 4; ++g) G0[g] = *(const v2u*)(gb + e_ + 8 * g); } } while (0)
    if (vcu < BATCH * NH * NCHUNK) C_LOAD(vcu, g0);
    for (int unit = vcu; unit < BATCH * NH * NCHUNK; unit += G) {
        const int bh = unit >> 7, n = unit & 127, b = bh >> 4, h = bh & 15; const size_t r0 = (size_t)b * SEQ + (size_t)n * 64;
        bf16x8 sf[8];
        { const bf16* Sg = kvs + (size_t)unit * 16384 + (size_t)(vblk * 32 + r32) * 128 + hi * 8;
#pragma unroll
          for (int d0 = 0; d0 < 8; ++d0) sf[d0] = *(const bf16x8*)(Sg + d0 * 16); }
        f32x4 bb[4];
        bb[0] = lw[0]; bb[1] = bb[0] + lw[1]; bb[2] = bb[1] + lw[2]; bb[3] = bb[2] + lw[3];
        *(LAS f32x4*)(tot + rg * 128 + c4) = bb[3];
        *(LAS bf16x8*)(Vt + att::v_st(sr, sc)) = st_v0; *(LAS bf16x8*)(Vt + att::v_st(32 + sr, sc)) = st_v1;
        __syncthreads();
        f32x4 offs, bm;
        { f32x4 S = (f32x4){0.f, 0.f, 0.f, 0.f}; const int gm = rg0 < 8 ? rg0 : 8;
          for (int g = 0; g < gm; ++g) S = S + *(const LAS f32x4*)(tot + g * 128 + c4);
          if (rg0 <= 8) { offs = S; f32x4 T = S; for (int g = rg0; g < 8; ++g) T = T + *(const LAS f32x4*)(tot + g * 128 + c4); bm = T; }
          else { bm = S; for (int g = 8; g < rg0; ++g) S = S + *(const LAS f32x4*)(tot + g * 128 + c4); offs = S; }
          if (rg != rg0) offs = offs + *(const LAS f32x4*)(tot + rg0 * 128 + c4); }
#pragma unroll
        for (int j = 0; j < 4; ++j) { const int row = 4 * rg + j; const f32x4 bf = bb[j] + offs; float kt[4], qt[4], qi[4];
            const float q4[4] = {__builtin_bit_cast(float, qw[j].x << 16), __builtin_bit_cast(float, qw[j].x & 0xffff0000u), __builtin_bit_cast(float, qw[j].y << 16), __builtin_bit_cast(float, qw[j].y & 0xffff0000u)};
#pragma unroll
            for (int e = 0; e < 4; ++e) { const float dm = bf[e] - bm[e];
                qi[e] = q4[e] * __expf(bf[e]); qt[e] = q4[e] * __expf(fminf(dm, 80.f)); kt[e] = (1.0f - __expf(lw[j][e])) * __expf(fminf(-dm, 80.f)); }
            const int off = KSWZ(row, c4 * 2);
            { v2u w; w.x = pk2(kt[0], kt[1]); w.y = pk2(kt[2], kt[3]); *(LAS v2u*)(Kt + off) = w; }
            { v2u w; w.x = pk2(qt[0], qt[1]); w.y = pk2(qt[2], qt[3]); *(LAS v2u*)(Qt + off) = w; }
            { v2u w; w.x = pk2(qi[0], qi[1]); w.y = pk2(qi[2], qi[3]); *(LAS v2u*)(Qi + off) = w; } }
        if (unit + G < BATCH * NH * NCHUNK) C_LOAD(unit + G, ng0);
        __syncthreads();
        bf16x8 qr[8];
#pragma unroll
        for (int d0 = 0; d0 < 8; ++d0) qr[d0] = *(const LAS bf16x8*)(Qt + KSWZ(tb * 32 + r32, (d0 * 16 + hi * 8) * 2));
        f32x16 p0 = f32x16{}, p1 = f32x16{};
        att::qkt128(p0, p1, Kt, r32, hi, qr);
        const int t = tb * 32 + r32;
#pragma unroll
        for (int r = 0; r < 16; ++r) { const int s = crow(r, hi); if (!(s <= t)) p0[r] = 0.f; if (!(s + 32 <= t)) p1[r] = 0.f; }
        bf16x8 pa0, pa1, pa2, pa3;
#define PK4(P, B_, OUT) do { unsigned a0_ = att::cvtpk(P[B_+0], P[B_+1]), a1_ = att::cvtpk(P[B_+2], P[B_+3]), b0_ = att::cvtpk(P[B_+4], P[B_+5]), b1_ = att::cvtpk(P[B_+6], P[B_+7]); \
        auto r0_ = __builtin_amdgcn_permlane32_swap(a0_, b0_, false, false); auto r1_ = __builtin_amdgcn_permlane32_swap(a1_, b1_, false, false); \
        v4u w_ = {r0_[0], r1_[0], r0_[1], r1_[1]}; OUT = __builtin_bit_cast(bf16x8, w_); } while (0)
        PK4(p0, 0, pa0); PK4(p0, 8, pa1); PK4(p1, 0, pa2); PK4(p1, 8, pa3);
#undef PK4
        f32x16 o = f32x16{};
        { bf16x8 fv; FRAG(fv, vbV, 0); o = __builtin_amdgcn_mfma_f32_32x32x16_bf16(fv, pa0, o, 0, 0, 0); FRAG(fv, vbV, 1); o = __builtin_amdgcn_mfma_f32_32x32x16_bf16(fv, pa1, o, 0, 0, 0);
          FRAG(fv, vbV, 2); o = __builtin_amdgcn_mfma_f32_32x32x16_bf16(fv, pa2, o, 0, 0, 0); FRAG(fv, vbV, 3); o = __builtin_amdgcn_mfma_f32_32x32x16_bf16(fv, pa3, o, 0, 0, 0); }
#pragma unroll
        for (int d0 = 0; d0 < 8; ++d0) { const bf16x8 qf = *(const LAS bf16x8*)(Qi + KSWZ(tb * 32 + r32, (d0 * 16 + hi * 8) * 2));
            o = __builtin_amdgcn_mfma_f32_32x32x16_bf16(sf[d0], qf, o, 0, 0, 0); }
        { float ss = 0.f;
#pragma unroll
          for (int r = 0; r < 16; ++r) ss += o[r] * o[r];
          { const unsigned u = __builtin_bit_cast(unsigned, ss); auto sw = __builtin_amdgcn_permlane32_swap(u, u, false, false); ss = __builtin_bit_cast(float, (unsigned)sw[0]) + __builtin_bit_cast(float, (unsigned)sw[1]); }
          if (hi == 0) sst[(tb * 32 + r32) * 4 + vblk] = ss;
          __syncthreads();
          const f32x4 s4 = *(const LAS f32x4*)(sst + (tb * 32 + r32) * 4);
          const float rs = __builtin_amdgcn_rsqf(((s4[0] + s4[1]) + (s4[2] + s4[3])) * (1.0f / 128.0f) + RMS_EPS);
          float y[16];
#pragma unroll
          for (int g = 0; g < 4; ++g) {
              const float gg4[4] = {__builtin_bit_cast(float, g0[g].x << 16), __builtin_bit_cast(float, g0[g].x & 0xffff0000u), __builtin_bit_cast(float, g0[g].y << 16), __builtin_bit_cast(float, g0[g].y & 0xffff0000u)};
#pragma unroll
              for (int e = 0; e < 4; ++e) { const float gg = gg4[e]; y[4 * g + e] = o[4 * g + e] * rs * gn[g][e] * (gg * __builtin_amdgcn_rcpf(1.0f + __expf(-gg))); } }
          bf16* orow = ob + (r0 + tb * 32 + r32) * 2048 + h * 128 + 32 * vblk + hi * 8;
#pragma unroll
          for (int b8 = 0; b8 < 16; b8 += 8) {
              const unsigned a0_ = cvtpk_c(y[b8 + 0], y[b8 + 1]), a1_ = cvtpk_c(y[b8 + 2], y[b8 + 3]), b0_ = cvtpk_c(y[b8 + 4], y[b8 + 5]), b1_ = cvtpk_c(y[b8 + 6], y[b8 + 7]);
              auto r0_ = __builtin_amdgcn_permlane32_swap(a0_, b0_, false, false); auto r1_ = __builtin_amdgcn_permlane32_swap(a1_, b1_, false, false);
              *(v4u*)(orow + 2 * b8) = (v4u){r0_[0], r1_[0], r0_[1], r1_[1]}; } }
#pragma unroll
        for (int g = 0; g < 4; ++g) g0[g] = ng0[g];
    }
#undef C_LOAD
}
#undef KSWZ
#undef TRRD
#undef FRAG
}

struct Args { const float* in[19]; float* out; unsigned char* ws; int ph_lo, ph_hi, li, skip_mix; };

struct WDesc { const float* src; const float* gain; bf16* dst; int K, Nsrc, Nout, cmap; };
constexpr int NWMAT = 18;
__device__ __forceinline__ WDesc get_wdesc(int idx, const Args& a) {
    WDesc d; d.gain = nullptr; d.cmap = 0; unsigned char* ws = a.ws;
    if (idx < 2)       { d.src = a.in[5] + (size_t)idx * 2048 * 6144; d.K = 2048; d.Nsrc = d.Nout = 6144; d.gain = a.in[2] + (idx == 0 ? 0 : 3) * 2048; d.dst = (bf16*)(ws + W_SBQKV) + (size_t)idx * 6144 * 2048; }
    else if (idx < 4)  { const int j = idx - 2; d.src = a.in[6] + (size_t)j * 2048 * 2048; d.K = 2048; d.Nsrc = d.Nout = 2048; d.dst = (bf16*)(ws + W_SBWO) + (size_t)j * 2048 * 2048; }
    else if (idx == 4) { d.src = a.in[7]; d.K = 2048; d.Nsrc = d.Nout = 8192; d.gain = a.in[2] + 1 * 2048; d.dst = (bf16*)(ws + W_HGIN); }
    else if (idx == 5) { d.src = a.in[10]; d.K = 2048; d.Nsrc = d.Nout = 2048; d.dst = (bf16*)(ws + W_HGWO); }
    else if (idx == 6) { d.src = a.in[11]; d.K = 2048; d.Nsrc = 1344; d.Nout = 2048; d.gain = a.in[2] + 2 * 2048; d.cmap = 1; d.dst = (bf16*)(ws + W_DKV); }
    else if (idx == 7) { d.src = a.in[14]; d.K = 768; d.Nsrc = d.Nout = 3072; d.gain = a.in[12]; d.cmap = 2; d.dst = (bf16*)(ws + W_UQ); }
    else if (idx == 8) { d.src = a.in[15]; d.K = 512; d.Nsrc = d.Nout = 4096; d.gain = a.in[13]; d.dst = (bf16*)(ws + W_UKV); }
    else if (idx == 9) { d.src = a.in[16]; d.K = 2048; d.Nsrc = d.Nout = 2048; d.dst = (bf16*)(ws + W_MLAWO); }
    else if (idx < 14) { const int L = idx - 10; d.src = a.in[17] + (size_t)L * 2048 * 8192; d.K = 2048; d.Nsrc = d.Nout = 8192; d.gain = a.in[3] + L * 2048; d.dst = (bf16*)(ws + W_W1) + (size_t)L * 8192 * 2048; }
    else               { const int L = idx - 14; d.src = a.in[18] + (size_t)L * 8192 * 2048; d.K = 8192; d.Nsrc = d.Nout = 2048; d.dst = (bf16*)(ws + W_W2) + (size_t)L * 2048 * 8192; }
    return d;
}
__device__ __forceinline__ int wmap_col(int cmap, int n) {
    if (cmap == 1) { if (n < 1280) return n; if (n < 1344) { const int j = n - 1280; return 1280 + (j & 1) * 32 + (j >> 1); } return -1; }
    if (cmap == 2) { const int h = n / 192, c = n % 192; if (c < 128) return n; const int j = c - 128; return h * 192 + 128 + (j & 1) * 32 + (j >> 1); }
    return n;
}
__device__ __forceinline__ void p0_item_load(const WDesc& d, int item, int lane, float (&wv)[32]) {
    const int nblk = d.Nout / 32, kb = item / nblk, nb = item % nblk, k0 = 64 * kb, n0 = 32 * nb;
    const int src = wmap_col(d.cmap, n0 + (lane & 31));
    const float* sp = d.src + (size_t)(k0 + (lane >> 5)) * d.Nsrc + (src >= 0 ? src : 0);
#pragma unroll
    for (int i = 0; i < 32; ++i) wv[i] = __builtin_nontemporal_load(sp + (size_t)(2 * i) * d.Nsrc);
}
__device__ __forceinline__ void p0_item_store(const WDesc& d, LAS float* scr, int item, int lane, const float (&wv)[32]) {
    const int nblk = d.Nout / 32, kb = item / nblk, nb = item % nblk, k0 = 64 * kb, n0 = 32 * nb;
    const int src = wmap_col(d.cmap, n0 + (lane & 31));
#pragma unroll
    for (int i = 0; i < 32; ++i) { const int kk = 2 * i + (lane >> 5); scr[kk * 33 + (lane & 31)] = (src >= 0) ? wv[i] : 0.f; }
    LDS_WAIT(); asm volatile("" ::: "memory");
    const int c = lane & 7;
    f32x4 g0 = (f32x4){1.f, 1.f, 1.f, 1.f}, g1 = g0;
    if (d.gain) { g0 = *(const f32x4*)(d.gain + k0 + 8 * c); g1 = *(const f32x4*)(d.gain + k0 + 8 * c + 4); }
#pragma unroll
    for (int j = 0; j < 4; ++j) { const int n = (lane >> 3) + 8 * j; const LAS float* s = scr + (8 * c) * 33 + n;
        v4u o; o.x = pk2(s[0 * 33] * g0[0], s[1 * 33] * g0[1]); o.y = pk2(s[2 * 33] * g0[2], s[3 * 33] * g0[3]); o.z = pk2(s[4 * 33] * g1[0], s[5 * 33] * g1[1]); o.w = pk2(s[6 * 33] * g1[2], s[7 * 33] * g1[3]);
        *(GAS v4u*)(d.dst + (size_t)(n0 + n) * d.K + k0 + 8 * c) = o; }
    LDS_WAIT(); asm volatile("" ::: "memory");
}
__device__ __forceinline__ void p0_prologue(const Args& a, LAS unsigned char* lds, int vcu, int NGW) {
    int tid_ = threadIdx.x; asm volatile("" : "+v"(tid_)); const int lane = tid_ & 63, wave = __builtin_amdgcn_readfirstlane(tid_ >> 6), gw = vcu * NWAVES + wave;
    LAS float* scr = (LAS float*)(lds + RING_OFF + wave * 16384);
    int off = 0;
#define CONVERT_W(w) { const WDesc d = get_wdesc(w, a); const int cnt = (d.K / 64) * (d.Nout / 32); int it = ((gw - off) % NGW + NGW) % NGW; float wa[32], wb[32]; \
        if (it < cnt) p0_item_load(d, it, lane, wa); \
        for (; it < cnt; it += 2 * NGW) { if (it + NGW < cnt) p0_item_load(d, it + NGW, lane, wb); p0_item_store(d, scr, it, lane, wa); \
            if (it + NGW < cnt) { if (it + 2 * NGW < cnt) p0_item_load(d, it + 2 * NGW, lane, wa); p0_item_store(d, scr, it + NGW, lane, wb); } } off += cnt; }
    CONVERT_W(0) CONVERT_W(1) CONVERT_W(2) CONVERT_W(3) CONVERT_W(4) CONVERT_W(5) CONVERT_W(6) CONVERT_W(7) CONVERT_W(8) CONVERT_W(9)
    CONVERT_W(10) CONVERT_W(11) CONVERT_W(12) CONVERT_W(13) CONVERT_W(14) CONVERT_W(15) CONVERT_W(16) CONVERT_W(17)
#undef CONVERT_W
    pg8::u64* rowss = (pg8::u64*)(a.ws + WS_CTL + CTL_ROWSS); bf16* ab = (bf16*)(a.ws + WS_AB);
    for (int m = gw; m < M; m += NGW) {
        const GAS f32x4* xr = (const GAS f32x4*)(a.in[0] + (size_t)m * DM) + lane; GAS v2u* o8 = (GAS v2u*)(ab + (size_t)m * DM) + lane;
        f32x4 v[8]; float s = 0.f;
#pragma unroll
        for (int j = 0; j < 8; ++j) { v[j] = __builtin_nontemporal_load(xr + 64 * j); s += pg8::dot4(v[j]); }
        s = wave_sum(s);
#pragma unroll
        for (int j = 0; j < 8; ++j) { v2u w; w.x = pk2(v[j][0], v[j][1]); w.y = pk2(v[j][2], v[j][3]); o8[64 * j] = w; }
        if (lane == 0) rowss[m] = (pg8::u64)(long long)((double)s * pg8::RSS_FIX);
    }
    { const int* pos = (const int*)a.in[1]; float* cs = (float*)(a.ws + WS_CS);
      for (int e = gw * 64 + lane; e < M * 32; e += NGW * 64) { const int row = e >> 5, i = e & 31;
          const float inv_freq = exp2f(-(float)(2 * i) * (13.287712379549449f / 64.0f));
          const float ang = (float)pos[row] * inv_freq;
          double t = (double)ang * 0.15915494309189535; t -= floor(t);
          const float fr = (float)t;
          f32x2 o; o.x = __builtin_amdgcn_cosf(fr); o.y = __builtin_amdgcn_sinf(fr);
          *(f32x2*)(cs + (size_t)e * 2) = o; } }
    { const float* lg = a.in[8]; float* tab = (float*)(a.ws + WS_TAB);
      for (int c = gw * 64 + lane; c < 2048; c += NGW * 64) {
          const float l0 = lg[c], l1 = lg[2048 + c], l2 = lg[4096 + c], l3 = lg[6144 + c];
          const float mx = fmaxf(fmaxf(l0, l1), fmaxf(l2, l3));
          const float e0 = expf(l0 - mx), e1 = expf(l1 - mx), e2 = expf(l2 - mx), e3 = expf(l3 - mx); const float sum = (e0 + e1) + (e2 + e3);
          const float p0 = e0 / sum, p1 = e1 / sum; const float lb = (p0 + p1) - p0;
          tab[c] = logf(lb); tab[2048 + c] = log1pf(-lb); tab[4096 + c] = lb; tab[6144 + c] = 1.0f - lb; } }
}
__device__ __forceinline__ void final_norm_phase(const Args& a, int vcu, int NGW) {
    int tid_ = threadIdx.x; asm volatile("" : "+v"(tid_)); const int lane = tid_ & 63, gw = vcu * NWAVES + __builtin_amdgcn_readfirstlane(tid_ >> 6);
    const pg8::u64* rowss = (const pg8::u64*)(a.ws + WS_CTL + CTL_ROWSS) + 8 * (size_t)M; const float* gn = a.in[4];
    f32x4 g[8];
#pragma unroll
    for (int j = 0; j < 4; ++j) { g[2 * j] = *((const f32x4*)gn + 2 * (64 * j + lane)); g[2 * j + 1] = *((const f32x4*)gn + 2 * (64 * j + lane) + 1); }
    const bf16* ab = (const bf16*)(a.ws + WS_AB);
    for (int m = gw; m < M; m += 2 * NGW) {
        const int m1 = (m + NGW < M) ? m + NGW : m;
        const GAS v4u* h0 = (const GAS v4u*)(ab + (size_t)m * DM) + lane; const GAS v4u* h1 = (const GAS v4u*)(ab + (size_t)m1 * DM) + lane;
        v4u w0[4], w1[4];
#pragma unroll
        for (int j = 0; j < 4; ++j) { w0[j] = h0[64 * j]; w1[j] = h1[64 * j]; }
        const float rs0 = 1.0f / sqrtf(pg8::rowss_get(rowss + m) * (1.0f / DM) + RMS_EPS), rs1 = 1.0f / sqrtf(pg8::rowss_get(rowss + m1) * (1.0f / DM) + RMS_EPS);
        GAS f32x4* x0 = (GAS f32x4*)(a.out + (size_t)m * DM) + 2 * lane; GAS f32x4* x1 = (GAS f32x4*)(a.out + (size_t)m1 * DM) + 2 * lane;
#pragma unroll
        for (int j = 0; j < 4; ++j) {
            { const v4u w = w0[j]; f32x4 lo, hi4; lo[0] = __builtin_bit_cast(float, w.x << 16); lo[1] = __builtin_bit_cast(float, w.x & 0xffff0000u); lo[2] = __builtin_bit_cast(float, w.y << 16); lo[3] = __builtin_bit_cast(float, w.y & 0xffff0000u);
              hi4[0] = __builtin_bit_cast(float, w.z << 16); hi4[1] = __builtin_bit_cast(float, w.z & 0xffff0000u); hi4[2] = __builtin_bit_cast(float, w.w << 16); hi4[3] = __builtin_bit_cast(float, w.w & 0xffff0000u);
              x0[128 * j] = lo * rs0 * g[2 * j]; x0[128 * j + 1] = hi4 * rs0 * g[2 * j + 1]; }
            if (m1 != m) { const v4u w = w1[j]; f32x4 lo, hi4; lo[0] = __builtin_bit_cast(float, w.x << 16); lo[1] = __builtin_bit_cast(float, w.x & 0xffff0000u); lo[2] = __builtin_bit_cast(float, w.y << 16); lo[3] = __builtin_bit_cast(float, w.y & 0xffff0000u);
              hi4[0] = __builtin_bit_cast(float, w.z << 16); hi4[1] = __builtin_bit_cast(float, w.z & 0xffff0000u); hi4[2] = __builtin_bit_cast(float, w.w << 16); hi4[3] = __builtin_bit_cast(float, w.w & 0xffff0000u);
              x1[128 * j] = lo * rs1 * g[2 * j]; x1[128 * j + 1] = hi4 * rs1 * g[2 * j + 1]; }
        }
    }
}

#ifndef WGM_G1
#define WGM_G1 4
#define WGM_UQ 4
#define WGM_WO 4
#define WGM_W1 4
#define WGM_W2 4
#endif
constexpr int PH_FINAL = 33, PH_END = 34;
__host__ __device__ __forceinline__ constexpr int ph_id(int L, int s) { return 1 + 8 * L + s; }

__global__ void __launch_bounds__(NWAVES * 64, 2) trunk_fwd(Args args) {
    extern __shared__ __attribute__((aligned(16))) unsigned char lds_raw[];
    LAS unsigned char* lds = (LAS unsigned char*)lds_raw;
    volatile LAS unsigned* MISC = (volatile LAS unsigned*)(lds + MISC_OFF);
    const int tid = threadIdx.x;
    const int G = gridDim.x; const int bx = blockIdx.x; const int vcu = (G % 8 == 0) ? (bx % 8) * (G / 8) + bx / 8 : bx;
    const int NGW = G * NWAVES;
    unsigned char* ws = args.ws;
    gu32* ctl = (gu32*)(ws + WS_CTL);
    for (int u = tid; u < (LDS_BYTES - LDSCTL_OFF) / 4; u += NWAVES * 64) ((LAS unsigned*)(lds + LDSCTL_OFF))[u] = 0u;
    __syncthreads();
    XcdBarrier bar = xcd_barrier_post((unsigned*)(ctl + CW_BAR) + args.li * XCD_BAR_WORDS, MISC + 8);
    const int lo = args.ph_lo, hi = args.ph_hi;
#define IN(k) (lo <= (k) && (k) < hi)
#define END_PHASE(k) do { if (hi > (k) + 1) xcd_barrier(bar); } while (0)

    bf16* abuf = (bf16*)(ws + WS_AB); bf16* obuf = (bf16*)(ws + WS_OB); unsigned char* big = ws + WS_BIG;

    if (IN(0)) { p0_prologue(args, lds, vcu, NGW); END_PHASE(0); }

    for (int L = 0; L < DEPTH; ++L) {
        const int type = L % 3, j = L / 3;
        const bool own_mix = ((args.skip_mix >> type) & 1) == 0;
        if (IN(ph_id(L, 0))) {
            pg8::EpiMulti E{}; E.rs_idx = 2 * L; E.inv_k = 1.0f / DM; E.ws = ws; E.qscale = 1.f;
            pg8::Gemm g; g.A = abuf; g.M = M; g.K = DM;
            if (type == 0)      { g.Bt = (const bf16*)(ws + W_SBQKV) + (size_t)j * 6144 * 2048; g.N = 6144; E.mode = pg8::EM_SBQKV; E.qscale = 0.08838834764831845f * LOG2E; }
            else if (type == 1) { g.Bt = (const bf16*)(ws + W_HGIN); g.N = 8192; E.mode = pg8::EM_HG; }
            else                { g.Bt = (const bf16*)(ws + W_DKV); g.N = MLA_DKV_NP; E.mode = pg8::EM_DKV; }
            pg8::StaticOrder S; S.init(M, g.N, G, bx, WGM_G1);
            pg8::gemm_phase<pg8::EpiMulti, pg8::StaticOrder, true, true>(lds + RING_OFF, g, S, E);
            END_PHASE(ph_id(L, 0));
        }
        if (type == 2 && IN(ph_id(L, 1))) {
            { pg8::EpiMulti E{}; E.mode = pg8::EM_UQ; E.rs_idx = RS_Q; E.inv_k = 1.0f / MLA_QR; E.ws = ws; E.qscale = 0.07216878364870322f * LOG2E;
              pg8::Gemm g; g.A = (const bf16*)(big + BIG_CQ); g.Bt = (const bf16*)(ws + W_UQ); g.M = M; g.N = 3072; g.K = MLA_QR;
              pg8::StaticOrder S; S.init(M, g.N, G, bx, WGM_UQ);
              pg8::gemm_phase<pg8::EpiMulti, pg8::StaticOrder, true, true>(lds + RING_OFF, g, S, E); }
            { pg8::EpiMulti E{}; E.mode = pg8::EM_UKV; E.rs_idx = RS_KV; E.inv_k = 1.0f / MLA_KVR; E.ws = ws; E.qscale = 1.f;
              pg8::Gemm g; g.A = (const bf16*)(big + BIG_CKV); g.Bt = (const bf16*)(ws + W_UKV); g.M = M; g.N = 4096; g.K = MLA_KVR;
              pg8::StaticOrder S; S.init(M, g.N, G, bx, WGM_UQ);
              pg8::gemm_phase<pg8::EpiMulti, pg8::StaticOrder, true, true>(lds + RING_OFF, g, S, E); }
            END_PHASE(ph_id(L, 1));
        }
        if (type == 0 && own_mix && IN(ph_id(L, 1))) {
            att::sb_phase((const bf16*)(big + BIG_QKV), obuf, lds + RING_OFF, vcu, G);
            END_PHASE(ph_id(L, 1));
        }
        if (type == 1 && own_mix) {
            if (IN(ph_id(L, 1))) { hg::pass_a((const bf16*)(big + BIG_HI), (const float*)(big + BIG_HLF), (bf16*)(big + BIG_HKVS), (float*)(big + BIG_HDEC), lds + RING_OFF, vcu, G); END_PHASE(ph_id(L, 1)); }
            if (IN(ph_id(L, 2))) { hg::pass_b((bf16*)(big + BIG_HKVS), (const float*)(big + BIG_HDEC), lds + RING_OFF, vcu, G); END_PHASE(ph_id(L, 2)); }
            if (IN(ph_id(L, 3))) { hg::pass_c((const bf16*)(big + BIG_HQ), (const bf16*)(big + BIG_HI), (const bf16*)(big + BIG_HG), (const float*)(big + BIG_HLF), (const bf16*)(big + BIG_HKVS), args.in[9], obuf, lds + RING_OFF, vcu, G);
                                   END_PHASE(ph_id(L, 3)); }
        }
        if (type == 2 && own_mix && IN(ph_id(L, 2))) {
            att::mla_phase((const bf16*)(big + BIG_QM), (const bf16*)(big + BIG_KVM), (const bf16*)(big + BIG_KPE), obuf, lds + RING_OFF, vcu, G);
            END_PHASE(ph_id(L, 2));
        }
        if (IN(ph_id(L, 4))) {
            pg8::Gemm g; g.A = obuf; g.M = M; g.N = DM; g.K = DM;
            g.Bt = (type == 0) ? (const bf16*)(ws + W_SBWO) + (size_t)j * 2048 * 2048 : (type == 1) ? (const bf16*)(ws + W_HGWO) : (const bf16*)(ws + W_MLAWO);
            pg8::EpiResid E{(L == 0) ? args.in[0] : nullptr, ws, 2 * L + 1};
            pg8::StaticOrder S; S.init(M, g.N, G, bx, WGM_WO);
            pg8::gemm_phase<pg8::EpiResid, pg8::StaticOrder, true, true>(lds + RING_OFF, g, S, E);
            END_PHASE(ph_id(L, 4));
        }
        if (IN(ph_id(L, 5))) {
            pg8::EpiMulti E{}; E.mode = pg8::EM_RELU2; E.rs_idx = 2 * L + 1; E.inv_k = 1.0f / DM; E.ws = ws; E.qscale = 1.f;
            pg8::Gemm g; g.A = abuf; g.Bt = (const bf16*)(ws + W_W1) + (size_t)L * 8192 * 2048; g.M = M; g.N = DFF; g.K = DM;
            pg8::StaticOrder S; S.init(M, g.N, G, bx, WGM_W1);
            pg8::gemm_phase<pg8::EpiMulti, pg8::StaticOrder, true, true>(lds + RING_OFF, g, S, E);
            END_PHASE(ph_id(L, 5));
        }
        if (IN(ph_id(L, 6))) {
            pg8::Gemm g; g.A = (const bf16*)(big + BIG_HID); g.Bt = (const bf16*)(ws + W_W2) + (size_t)L * 2048 * 8192; g.M = M; g.N = DM; g.K = DFF;
            pg8::EpiResid E{nullptr, ws, 2 * L + 2};
            pg8::StaticOrder S; S.init(M, g.N, G, bx, WGM_W2, 1);
            pg8::gemm_phase<pg8::EpiResid, pg8::StaticOrder, true, true>(lds + RING_OFF, g, S, E);
            END_PHASE(ph_id(L, 6));
        }
    }
    if (IN(PH_FINAL)) final_norm_phase(args, vcu, NGW);
#undef IN
#undef END_PHASE
}

extern "C" void kernel_launch(void* const* d_in, const int* in_sizes, int n_in, void* d_out, int out_size, void* d_ws, size_t ws_size, hipStream_t stream) {
    static int grid = 0;
    if (grid == 0) {
        if (n_in != 19 || in_sizes[0] != M * DM || out_size != M * DM || ws_size < WS_END) { fprintf(stderr, "kernel_launch: unexpected shapes (n_in %d, in0 %d, out %d, ws %zu < %zu)\n", n_in, n_in > 0 ? in_sizes[0] : -1, out_size, ws_size, (size_t)WS_END); grid = -1; return; }
        int dev = 0, cus = 0, per_cu = 0;
        if (hipGetDevice(&dev) != hipSuccess || hipDeviceGetAttribute(&cus, hipDeviceAttributeMultiprocessorCount, dev) != hipSuccess) { grid = -1; return; }
        if (hipFuncSetAttribute((const void*)trunk_fwd, hipFuncAttributeMaxDynamicSharedMemorySize, LDS_BYTES) != hipSuccess) { fprintf(stderr, "kernel_launch: hipFuncSetAttribute failed\n"); grid = -1; return; }
        if (hipOccupancyMaxActiveBlocksPerMultiprocessor(&per_cu, (const void*)trunk_fwd, NWAVES * 64, LDS_BYTES) != hipSuccess || per_cu < 1) fprintf(stderr, "kernel_launch: occupancy query says %d\n", per_cu);
        (void)hipGetLastError();
        grid = cus;
    }
    if (grid < 0) return;
    (void)hipMemsetAsync((char*)d_ws + WS_CTL, 0, CTL_ZERO_BYTES, stream);
    Args a{};
    for (int i = 0; i < 19; ++i) a.in[i] = (const float*)d_in[i];
    a.out = (float*)d_out; a.ws = (unsigned char*)d_ws;
    a.ph_lo = 0; a.ph_hi = PH_END; a.li = 0; a.skip_mix = 0;
    hipLaunchKernelGGL(trunk_fwd, dim3(grid), dim3(NWAVES * 64), LDS_BYTES, stream, a);
}
```
